# Optimizing an MI355X kernel written in HIP

```python
import math
import jax, jax.numpy as jnp
from jax import lax
import numpy as np

D_MODEL = 2048
BATCH = 4
SEQ = 4096
DEPTH = 1

GRID_W = 64
CTX_LEN = 256

HY_WIDTH = 2048
HY_SHORT_K = 3
HY_EMB_DIM = 33
HY_FILTER_ORDER = 64
HY_MIN_DECAY = math.log(1e-2) / 1.5
HY_MAX_DECAY = math.log(1e-2) / 0.3

GDN_HEADS = 16
GDN_DK = 128
GDN_DV = 128
GDN_SHORT_K = 3
GDN_CHUNK = 64
D_QK = GDN_HEADS * GDN_DK
D_V = GDN_HEADS * GDN_DV

D_FF = -(-8 * D_MODEL // (3 * 256)) * 256

SPLITS = (3 * HY_WIDTH, 2 * D_QK + D_V, D_V, 4 * GDN_HEADS, 2 * D_MODEL)
D_IN = sum(SPLITS)
SPLIT_IDX = [int(s) for s in np.cumsum(SPLITS)[:-1]]

EPS = 1e-6

kernel_name = "hyena_gdn_hybrid_dit_block"


def rmsnorm(x, g):
    xf = x.astype(jnp.float32)
    xf = xf * lax.rsqrt(jnp.mean(xf * xf, axis=-1, keepdims=True) + EPS)
    return xf.astype(x.dtype) * g


def l2norm(x):
    xf = x.astype(jnp.float32)
    return xf * lax.rsqrt(jnp.sum(xf * xf, axis=-1, keepdims=True) + EPS)


def short_conv(x, w):
    k_w = w.shape[0]
    pad = k_w // 2
    n = x.shape[-2]
    xp = jnp.pad(x, [(0, 0)] * (x.ndim - 2) + [(pad, pad), (0, 0)])
    return sum(xp[..., i:i + n, :] * w[i] for i in range(k_w))


def grid_conv(x, w):
    b, n, ch = x.shape
    rows = n // GRID_W
    return short_conv(x.reshape(b, rows, GRID_W, ch), w).reshape(b, n, ch)


def hyena_filters(n, fw1, fb1, fw2, fb2, fw3, fb3, fout, freq):
    f32 = jnp.float32
    t = jnp.linspace(0.0, 1.0, n, dtype=f32)[:, None]
    bands = (HY_EMB_DIM - 1) // 2
    w = 2.0 * math.pi * jnp.arange(n, dtype=f32)[:, None] / n
    f = jnp.linspace(1e-4, bands - 1, bands, dtype=f32)[None, :]
    z = jnp.concatenate([t, jnp.cos(f * w), -jnp.sin(f * w)], axis=-1)
    h = jnp.sin(freq * (z @ fw1 + fb1))
    h = jnp.sin(freq * (h @ fw2 + fb2))
    h = jnp.sin(freq * (h @ fw3 + fb3))
    h = (h @ fout).reshape(n, 2, HY_WIDTH)
    deltas = jnp.abs(jnp.linspace(HY_MIN_DECAY, HY_MAX_DECAY, HY_WIDTH, dtype=f32))
    h = h * jnp.exp(-t * deltas)[:, None, :]
    h_fwd, h_bwd = h[:, 0], h[:, 1]
    return jnp.concatenate([h_fwd, jnp.zeros((1, HY_WIDTH), h.dtype), h_bwd[:0:-1]], axis=0)


def hyena_mix(p_hy, filt, hy_bias, conv_w, conv_fn):
    u = conv_fn(p_hy, conv_w)
    x0, x1, v = jnp.split(u, 3, axis=-1)
    z = x1 * v
    n = z.shape[1]
    zf = jnp.fft.rfft(z.astype(jnp.float32), n=2 * n, axis=1)
    kf = jnp.fft.rfft(filt.astype(jnp.float32), n=2 * n, axis=0)
    y = jnp.fft.irfft(zf * kf[None], n=2 * n, axis=1)[:, :n]
    return x0 * (y.astype(z.dtype) + z * hy_bias)


def gdn_chunked(q, k, v, g, beta, s0):
    f32 = jnp.float32
    b, n, h, dk = q.shape
    dv = v.shape[-1]
    c = GDN_CHUNK
    nc = n // c

    def chunks(t):
        return jnp.moveaxis(t.astype(f32).reshape(b, nc, c, h, *t.shape[3:]), 3, 1)

    q, k, v, g, beta = (chunks(t) for t in (q, k, v, g, beta))
    q = q * (dk ** -0.5)
    g = jnp.cumsum(g, axis=-1)
    tril = jnp.tril(jnp.ones((c, c), bool))
    strict = jnp.tril(jnp.ones((c, c), bool), -1)
    decay = jnp.exp(jnp.where(tril, g[..., :, None] - g[..., None, :], -jnp.inf))
    kb = k * beta[..., None]
    a_mat = jnp.where(strict, jnp.einsum('bhncd,bhnsd->bhncs', kb, k) * decay, 0.0)
    rhs = jnp.concatenate([v * beta[..., None], kb * jnp.exp(g)[..., None]], axis=-1)
    sol = lax.linalg.triangular_solve(jnp.eye(c, dtype=f32) + a_mat, rhs,
                                      left_side=True, lower=True, unit_diagonal=True)
    u, w = sol[..., :dv], sol[..., dv:]
    qk = jnp.where(tril, jnp.einsum('bhncd,bhnsd->bhncs', q, k) * decay, 0.0)
    q_dec = q * jnp.exp(g)[..., None]
    g_last = g[..., -1]
    k_dec = k * jnp.exp(g_last[..., None] - g)[..., None]

    def step(s, xs):
        q_i, w_i, u_i, k_i, qk_i, gl_i = xs
        v_new = u_i - jnp.einsum('bhcd,bhde->bhce', w_i, s)
        o = jnp.einsum('bhcd,bhde->bhce', q_i, s) + jnp.einsum('bhcs,bhse->bhce', qk_i, v_new)
        s = s * jnp.exp(gl_i)[..., None, None] + jnp.einsum('bhcd,bhce->bhde', k_i, v_new)
        return s, o

    xs = tuple(jnp.moveaxis(t, 2, 0) for t in (q_dec, w, u, k_dec, qk, g_last))
    s_final, o = lax.scan(step, s0, xs)
    o = jnp.moveaxis(jnp.moveaxis(o, 0, 2), 1, 3).reshape(b, n, h, dv)
    return o, s_final


def gdn_core(p_qkv, p_scal, conv_fn, s_f0, s_b0, lp):
    b, n, _ = p_qkv.shape
    qkv = jax.nn.silu(conv_fn(p_qkv, lp['gdn_conv']))
    q, k, v = jnp.split(qkv, [D_QK, 2 * D_QK], axis=-1)
    q = l2norm(q.reshape(b, n, GDN_HEADS, GDN_DK))
    k = l2norm(k.reshape(b, n, GDN_HEADS, GDN_DK))
    v = v.reshape(b, n, GDN_HEADS, GDN_DV)
    s = p_scal.astype(jnp.float32).reshape(b, n, 2, 2, GDN_HEADS)
    beta = jax.nn.sigmoid(s[:, :, 0])
    g = -jnp.exp(lp['gdn_a_log']) * jax.nn.softplus(s[:, :, 1] + lp['gdn_dt_bias'])
    o_f, s_f = gdn_chunked(q, k, v, g[:, :, 0], beta[:, :, 0], s_f0)
    rev = lambda t: jnp.flip(t, axis=1)
    o_b, s_b = gdn_chunked(rev(q), rev(k), rev(v), rev(g[:, :, 1]), rev(beta[:, :, 1]), s_b0)
    return (o_f + rev(o_b)).astype(p_qkv.dtype), s_f, s_b


def mixer_out(p_hy, p_z, p_gate, o_gdn, conv_fn, lp):
    n = p_hy.shape[1]
    filt = hyena_filters(n, lp['hy_fw1'], lp['hy_fb1'], lp['hy_fw2'], lp['hy_fb2'],
                         lp['hy_fw3'], lp['hy_fb3'], lp['hy_fout'], lp['hy_freq'])
    y_hy = hyena_mix(p_hy, filt, lp['hy_bias'], lp['hy_conv'], conv_fn) @ lp['w_hy_out']
    b = o_gdn.shape[0]
    z = p_z.reshape(b, n, GDN_HEADS, GDN_DV)
    y_gdn = (rmsnorm(o_gdn, lp['gdn_norm']) * jax.nn.silu(z)).reshape(b, n, D_V) @ lp['w_gdn_out']
    g_hy, g_gdn = jnp.split(jax.nn.sigmoid(p_gate), 2, axis=-1)
    return (g_hy * y_hy + g_gdn * y_gdn) @ lp['w_o']


def swiglu(h, w_up, w_down):
    gate, up = jnp.split(h @ w_up, 2, axis=-1)
    return (jax.nn.silu(gate) * up) @ w_down


def setup_inputs(seed: int = 0) -> dict:
    key = jax.random.key(seed)
    ks = iter(jax.random.split(key, 40))
    f32 = jnp.float32

    def nrm(shape, scale):
        return jax.random.normal(next(ks), shape, f32) * scale

    def gain(shape):
        return 1.0 + nrm(shape, 0.01)

    dt = jnp.exp(jax.random.uniform(next(ks), (DEPTH, 2, GDN_HEADS), f32, math.log(1e-3), math.log(1e-1)))
    return {
        'x': nrm((BATCH, SEQ, D_MODEL), 1.0),
        'c': nrm((BATCH, D_MODEL), 1.0),
        'ctx': nrm((BATCH, CTX_LEN, D_MODEL), 1.0),
        'c_ctx': nrm((D_MODEL,), 1.0),
        'w_ada': nrm((DEPTH, D_MODEL, 6 * D_MODEL), D_MODEL ** -0.5),
        'b_ada': nrm((DEPTH, 6 * D_MODEL), 0.01),
        'norm_mix': gain((DEPTH, D_MODEL)),
        'norm_ffn': gain((DEPTH, D_MODEL)),
        'w_in': nrm((DEPTH, D_MODEL, D_IN), D_MODEL ** -0.5),
        'hy_conv': nrm((DEPTH, HY_SHORT_K, 3 * HY_WIDTH), HY_SHORT_K ** -0.5),
        'hy_bias': nrm((DEPTH, HY_WIDTH), 1.0),
        'hy_fw1': nrm((DEPTH, HY_EMB_DIM, HY_FILTER_ORDER), HY_EMB_DIM ** -0.5),
        'hy_fb1': nrm((DEPTH, HY_FILTER_ORDER), 0.1),
        'hy_fw2': nrm((DEPTH, HY_FILTER_ORDER, HY_FILTER_ORDER), HY_FILTER_ORDER ** -0.5),
        'hy_fb2': nrm((DEPTH, HY_FILTER_ORDER), 0.1),
        'hy_fw3': nrm((DEPTH, HY_FILTER_ORDER, HY_FILTER_ORDER), HY_FILTER_ORDER ** -0.5),
        'hy_fb3': nrm((DEPTH, HY_FILTER_ORDER), 0.1),
        'hy_fout': nrm((DEPTH, HY_FILTER_ORDER, 2 * HY_WIDTH), 0.02),
        'hy_freq': gain((DEPTH, HY_FILTER_ORDER)),
        'gdn_conv': nrm((DEPTH, GDN_SHORT_K, 2 * D_QK + D_V), GDN_SHORT_K ** -0.5),
        'gdn_a_log': jnp.log(jax.random.uniform(next(ks), (DEPTH, 2, GDN_HEADS), f32, 1.0, 16.0)),
        'gdn_dt_bias': dt + jnp.log(-jnp.expm1(-dt)),
        'gdn_norm': gain((DEPTH, GDN_DV)),
        'w_hy_out': nrm((DEPTH, HY_WIDTH, D_MODEL), HY_WIDTH ** -0.5),
        'w_gdn_out': nrm((DEPTH, D_V, D_MODEL), D_V ** -0.5),
        'w_o': nrm((DEPTH, D_MODEL, D_MODEL), D_MODEL ** -0.5),
        'w_up': nrm((DEPTH, D_MODEL, 2 * D_FF), D_MODEL ** -0.5),
        'w_down': nrm((DEPTH, D_FF, D_MODEL), D_FF ** -0.5),
        'norm_final': gain((D_MODEL,)),
    }


def reference(x, c, ctx, c_ctx, w_ada, b_ada, norm_mix, norm_ffn, w_in, hy_conv, hy_bias,
              hy_fw1, hy_fb1, hy_fw2, hy_fb2, hy_fw3, hy_fb3, hy_fout, hy_freq,
              gdn_conv, gdn_a_log, gdn_dt_bias, gdn_norm, w_hy_out, w_gdn_out, w_o,
              w_up, w_down, norm_final):
    b = x.shape[0]
    zero_state = jnp.zeros((b, GDN_HEADS, GDN_DK, GDN_DV), jnp.float32)
    for l in range(DEPTH):
        lp = {
            'hy_conv': hy_conv[l], 'hy_bias': hy_bias[l],
            'hy_fw1': hy_fw1[l], 'hy_fb1': hy_fb1[l], 'hy_fw2': hy_fw2[l], 'hy_fb2': hy_fb2[l],
            'hy_fw3': hy_fw3[l], 'hy_fb3': hy_fb3[l], 'hy_fout': hy_fout[l], 'hy_freq': hy_freq[l],
            'gdn_conv': gdn_conv[l], 'gdn_a_log': gdn_a_log[l], 'gdn_dt_bias': gdn_dt_bias[l],
            'gdn_norm': gdn_norm[l], 'w_hy_out': w_hy_out[l], 'w_gdn_out': w_gdn_out[l], 'w_o': w_o[l],
        }
        mod_lat = (jax.nn.silu(c) @ w_ada[l] + b_ada[l])[:, None, :]
        mod_ctx = (jax.nn.silu(c_ctx) @ w_ada[l] + b_ada[l])[None, None, :]
        sh_a, sc_a, ga_a, sh_f, sc_f, ga_f = jnp.split(mod_lat, 6, axis=-1)
        csh_a, csc_a, cga_a, csh_f, csc_f, cga_f = jnp.split(mod_ctx, 6, axis=-1)

        h_ctx = rmsnorm(ctx, norm_mix[l]) * (1.0 + csc_a) + csh_a
        h_lat = rmsnorm(x, norm_mix[l]) * (1.0 + sc_a) + sh_a
        pc = jnp.split(h_ctx @ w_in[l], SPLIT_IDX, axis=-1)
        pl = jnp.split(h_lat @ w_in[l], SPLIT_IDX, axis=-1)
        o_c, s_f, s_b = gdn_core(pc[1], pc[3], short_conv, zero_state, zero_state, lp)
        o_l, _, _ = gdn_core(pl[1], pl[3], grid_conv, s_f, s_b, lp)
        x = x + ga_a * mixer_out(pl[0], pl[2], pl[4], o_l, grid_conv, lp)

        x = x + ga_f * swiglu(rmsnorm(x, norm_ffn[l]) * (1.0 + sc_f) + sh_f, w_up[l], w_down[l])

        if l < DEPTH - 1:
            ctx = ctx + cga_a * mixer_out(pc[0], pc[2], pc[4], o_c, short_conv, lp)
            ctx = ctx + cga_f * swiglu(rmsnorm(ctx, norm_ffn[l]) * (1.0 + csc_f) + csh_f, w_up[l], w_down[l])
    return rmsnorm(x, norm_final)
```

```cpp
#include <hip/hip_runtime.h>
#include <hip/hip_cooperative_groups.h>
#include <cstdio>
namespace cg = cooperative_groups;

#define DI __device__ __forceinline__
#define LAS __attribute__((address_space(3)))
typedef unsigned short bf16_t;
typedef short bf16x8 __attribute__((ext_vector_type(8)));
typedef float f32x4 __attribute__((ext_vector_type(4)));
typedef float f32x2 __attribute__((ext_vector_type(2)));
typedef float f32x16 __attribute__((ext_vector_type(16)));
typedef unsigned u32x4 __attribute__((ext_vector_type(4)));
typedef unsigned u32x2 __attribute__((ext_vector_type(2)));
typedef __bf16 bf16v2 __attribute__((ext_vector_type(2)));

#ifndef MULTI_LAUNCH
#define MULTI_LAUNCH 0
#endif

constexpr int D = 2048, NB = 4, SEQL = 4096, NTOK = 16384, CTXL = 256, NCTX = 1024, MTOT = 17408;
constexpr int NH = 16, DFF = 5632, DIN = 18496;
constexpr int COL_QKV = 6144, COL_Z = 12288, COL_SCAL = 14336, COL_GATE = 14400;
constexpr int NTHREADS = 512;
constexpr int LDS_BYTES = 135168;

constexpr size_t al256(size_t x) { return (x + 255) & ~(size_t)255; }
constexpr size_t OFF_BAR = 0;
constexpr size_t OFF_MODP = 16384;
constexpr size_t OFF_MOD  = al256(OFF_MODP + (size_t)16 * 5 * 12288 * 4);
constexpr size_t OFF_H3   = al256(OFF_MOD + (size_t)5 * 12288 * 4);
constexpr size_t OFF_GCG  = al256(OFF_H3 + (size_t)4096 * 64 * 4);
constexpr size_t OFF_SC   = al256(OFF_GCG + (size_t)8704 * 64 * 4);
constexpr size_t OFF_H    = al256(OFF_SC + (size_t)MTOT * 64 * 4);
constexpr size_t OFF_WTA  = al256(OFF_H + (size_t)MTOT * D * 2);
constexpr size_t OFF_WSM  = al256(OFF_WTA + (size_t)6400 * D * 2);
constexpr size_t OFF_BIG  = al256(OFF_WSM + (size_t)3 * D * D * 2);
constexpr size_t OFF_X    = al256(OFF_BIG + (size_t)MTOT * 6144 * 2);
constexpr size_t OFF_Y    = OFF_X + (size_t)NTOK * D * 2;
constexpr size_t OFF_HMIX = OFF_Y + (size_t)NTOK * D * 2;
constexpr size_t OFF_WTB  = OFF_HMIX + (size_t)NTOK * D * 2;
constexpr size_t OFF_TMG  = OFF_WTB;
constexpr size_t WS_END   = OFF_TMG + (size_t)8704 * 3072 * 2;
constexpr size_t OFF_TAPS = OFF_TMG;
constexpr size_t SZ67     = (size_t)NTOK * D * 2;
constexpr size_t OFF_GATE = OFF_Y;
constexpr size_t OFF_WUP  = OFF_X;
constexpr size_t OFF_WDN  = OFF_X + (size_t)11264 * D * 2;

struct Params { const float* in[29]; float* out; unsigned char* ws; };

DI unsigned pk2(float lo, float hi) { f32x2 v = {lo, hi}; return __builtin_bit_cast(unsigned, __builtin_convertvector(v, bf16v2)); }
DI float bflo(unsigned w) { return __uint_as_float(w << 16); }
DI float bfhi(unsigned w) { return __uint_as_float(w & 0xffff0000u); }
DI float bf2f(bf16_t v) { return __uint_as_float(((unsigned)v) << 16); }
DI bf16_t f2bf(float f) { return (bf16_t)(pk2(f, 0.f) & 0xffffu); }
DI float sigmoidf_(float x) { return __builtin_amdgcn_rcpf(1.0f + __expf(-x)); }
DI float siluf_(float x) { return x * __builtin_amdgcn_rcpf(1.0f + __expf(-x)); }
DI float wave_sum(float v) {
#pragma unroll
    for (int o = 32; o >= 1; o >>= 1) v += __shfl_xor(v, o);
    return v;
}
DI int tidx() { int t = threadIdx.x; asm volatile("" : "+v"(t)); return t; }
DI int crow(int reg, int h) { return (reg & 3) + 8 * (reg >> 2) + 4 * h; }
#define LDS_BARRIER() do { asm volatile("s_waitcnt lgkmcnt(0)" ::: "memory"); __builtin_amdgcn_s_barrier(); asm volatile("" ::: "memory"); } while (0)
#define MFMA32(a, b, c) __builtin_amdgcn_mfma_f32_32x32x16_bf16((a), (b), (c), 0, 0, 0)

namespace pg8 {
constexpr int BM = 256, BK = 64, HALF = 128, HTB = HALF * BK * 2, STAGE_BYTES = 8 * HTB, NXCD = 8, WGM = 8;
DI int lds_byte(int r, int c) { const int st = (r >> 4) * 2 + (c >> 5), rr = r & 15, cc = c & 31, ob = rr * 64 + cc * 2; return st * 1024 + (ob ^ (((ob >> 9) & 1) << 5)); }
DI void stage_rc(int b, int& R, int& C) { const int st = b / 1024, sb = b % 1024, swz = sb ^ (((sb >> 9) & 1) << 5); R = (st >> 1) * 16 + swz / 64; C = (st & 1) * 32 + (swz % 64) / 2; }
DI int perm32(int rho) { const int n = rho >> 4, i = rho & 15; return 8 * (i >> 2) + 4 * n + (i & 3); }
struct Unit { int pm, pn; };
struct Gemm { const bf16_t* A; const bf16_t* Bt; int M, N, K; };
struct StaticOrder {
    int nM, nN, nwg, G, c;
    DI void init(int M, int N, int G_, int c_) { nM = M / BM; nN = N / BM; nwg = nM * nN; G = G_; c = c_; }
    DI bool next(int i, Unit& u) const {
        const long Lx = (long)i * G + c; if (Lx >= nwg) return false;
        int wgid = (int)Lx; { const int q = nwg / NXCD, r = nwg % NXCD, xcd = wgid % NXCD, off = wgid / NXCD; wgid = (xcd < r ? xcd * (q + 1) : r * (q + 1) + (xcd - r) * q) + off; }
        const int nig = WGM * nN, gid = wgid / nig, fm = gid * WGM, gsz = (nM - fm) < WGM ? (nM - fm) : WGM;
        u.pm = fm + ((wgid % nig) % gsz); u.pn = (wgid % nig) / gsz; return true;
    }
};
struct DynOrder {
    int nN, ntiles; unsigned* counters; volatile LAS int* slot;
    DI bool next(int, Unit& u) const {
        if (threadIdx.x == 0) {
            const int chunk = ntiles >> 3; const int x0 = (int)(__builtin_amdgcn_s_getreg((3 << 11) | 20) & 7u); int t0 = -1;
            for (int a = 0; a < 8; ++a) { const int j = (x0 + a) & 7;
                const int c = (int)__hip_atomic_fetch_add(counters + 16 * j, 1u, __ATOMIC_RELAXED, __HIP_MEMORY_SCOPE_AGENT);
                if (c < chunk) { t0 = j * chunk + c; break; } }
            *slot = t0; }
        asm volatile("s_waitcnt lgkmcnt(0)" ::: "memory"); __builtin_amdgcn_s_barrier(); asm volatile("" ::: "memory");
        const int t = __builtin_amdgcn_readfirstlane(*slot);
        if (t < 0) return false;
        const int nig = WGM * nN, gid = t / nig, wi = t - gid * nig;
        u.pm = gid * WGM + (wi & (WGM - 1)); u.pn = wi / WGM; return true;
    }
};
struct RangeOrder {
    int nN, first, count;
    DI bool next(int i, Unit& u) const { if (i >= count) return false; const int t = first + i; u.pm = t / nN; u.pn = t - u.pm * nN; return true; }
};
template <class Epi, class Sched>
DI void gemm_phase(LAS unsigned char* lds, const Gemm g, const Sched& S, const Epi& E) {
    const int tid = tidx(), wid = __builtin_amdgcn_readfirstlane(tid >> 6), lane = tid & 63, wr = wid >> 2, wc = wid & 3, fr = lane & 15, fq = lane >> 4;
    const int K = g.K, nt = K / BK;
    unsigned voffA[2], voffB[2];
#pragma unroll
    for (int i = 0; i < 2; ++i) { int R, C; stage_rc(tid * 16 + i * 8192, R, C); const int Rb = Epi::PERM ? ((R & ~31) + perm32(R & 31)) : R;
        voffA[i] = (unsigned)(R * K + C) * 2u; voffB[i] = (unsigned)(Rb * K + C) * 2u; }
    const size_t kstep = (size_t)(BK * 2);
    const size_t hstep = (size_t)HALF * K * 2;
    const size_t tstep = 2 * hstep;
    const unsigned ldsw = (unsigned)wid * 1024u;
    const int aoff = lds_byte(wr * 64 + fr, fq * 8), boff = lds_byte(wc * 32 + fr, fq * 8);
#define PG8_SA(b, h) (((b) * 2 + (h)) * HTB)
#define PG8_SB(b, h) ((4 + (b) * 2 + (h)) * HTB)
#define PG8_STAGE(bufoff, gbase, voff) do { _Pragma("unroll") for (int _i = 0; _i < 2; ++_i) \
        __builtin_amdgcn_global_load_lds((const unsigned*)((const char*)(gbase) + (voff)[_i]), (LAS unsigned*)(lds + (bufoff) + ldsw + _i * 8192), 16, 0, 0); } while (0)
#define PG8_LDA(dst, b, h) do { _Pragma("unroll") for (int m = 0; m < 4; ++m) _Pragma("unroll") for (int k = 0; k < 2; ++k) dst[m][k] = *(const LAS bf16x8*)(lds + PG8_SA(b, h) + aoff + m * 2048 + k * 1024); } while (0)
#define PG8_LDB(dst, b, h) do { _Pragma("unroll") for (int n = 0; n < 2; ++n) _Pragma("unroll") for (int k = 0; k < 2; ++k) dst[n][k] = *(const LAS bf16x8*)(lds + PG8_SB(b, h) + boff + n * 2048 + k * 1024); } while (0)
#define PG8_MMA(ai, bj, At, Bt) do { __builtin_amdgcn_s_setprio(1); _Pragma("unroll") for (int m = 0; m < 4; ++m) _Pragma("unroll") for (int n = 0; n < 2; ++n) _Pragma("unroll") for (int k = 0; k < 2; ++k) \
        acc[ai][bj][m][n] = __builtin_amdgcn_mfma_f32_16x16x32_bf16(Bt[n][k], At[m][k], acc[ai][bj][m][n], 0, 0, 0); __builtin_amdgcn_s_setprio(0); } while (0)
#define PG8_WAIT_V(n) asm volatile("s_waitcnt vmcnt(" #n ")" ::: "memory")
#define PG8_WAIT_L(n) asm volatile("s_waitcnt lgkmcnt(" #n ")" ::: "memory")
#define PG8_BAR __builtin_amdgcn_s_barrier()
#define PG8_SCHED __builtin_amdgcn_sched_barrier(0)
    Unit cur, nxt; int ui = 0;
    if (!S.next(0, cur)) return;
    f32x4 acc[2][2][4][2];
#pragma unroll
    for (int a = 0; a < 2; ++a)
#pragma unroll
        for (int b = 0; b < 2; ++b)
#pragma unroll
            for (int m = 0; m < 4; ++m)
#pragma unroll
                for (int n = 0; n < 2; ++n) acc[a][b][m][n] = (f32x4){0.f, 0.f, 0.f, 0.f};
    bf16x8 At[4][2], B0[2][2], B1[2][2];
    const char* cA = (const char*)g.A + (size_t)cur.pm * tstep; const char* cB = (const char*)g.Bt + (size_t)cur.pn * tstep;
    PG8_STAGE(PG8_SB(0, 0), cB, voffB); PG8_STAGE(PG8_SA(0, 0), cA, voffA); PG8_STAGE(PG8_SB(0, 1), cB + hstep, voffB); PG8_STAGE(PG8_SA(0, 1), cA + hstep, voffA);
    if (wr == 1) PG8_BAR;
    PG8_WAIT_V(4); PG8_BAR;
    PG8_STAGE(PG8_SB(1, 0), cB + kstep, voffB); PG8_STAGE(PG8_SA(1, 0), cA + kstep, voffA); PG8_STAGE(PG8_SB(1, 1), cB + hstep + kstep, voffB);
    PG8_WAIT_V(6); PG8_BAR;
    for (;;) {
        const bool has_next = S.next(ui + 1, nxt);
        const char* nA = has_next ? (const char*)g.A + (size_t)nxt.pm * tstep : cA; const char* nB = has_next ? (const char*)g.Bt + (size_t)nxt.pn * tstep : cB;
        for (int t = 0; t < nt; t += 2) {
            const bool last = (t == nt - 2);
            const char* a1 = cA + (size_t)(t + 1) * kstep;
            const char* a2 = last ? nA : cA + (size_t)(t + 2) * kstep; const char* b2 = last ? nB : cB + (size_t)(t + 2) * kstep;
            const char* a3 = a2 + kstep; const char* b3 = b2 + kstep;
            PG8_LDB(B0, 0, 0); PG8_SCHED; PG8_LDA(At, 0, 0); PG8_STAGE(PG8_SA(1, 1), a1 + hstep, voffA);
            PG8_WAIT_L(8); PG8_BAR; PG8_WAIT_L(0); PG8_MMA(0, 0, At, B0); PG8_BAR; PG8_SCHED;
            PG8_LDB(B1, 0, 1); PG8_STAGE(PG8_SB(0, 0), b2, voffB);
            PG8_BAR; PG8_WAIT_L(0); PG8_MMA(0, 1, At, B1); PG8_BAR;
            PG8_LDA(At, 0, 1); PG8_STAGE(PG8_SA(0, 0), a2, voffA);
            PG8_BAR; PG8_WAIT_L(0); PG8_MMA(1, 0, At, B0); PG8_BAR; PG8_SCHED;
            PG8_STAGE(PG8_SB(0, 1), b2 + hstep, voffB);
            PG8_WAIT_V(6); PG8_BAR; PG8_MMA(1, 1, At, B1); PG8_BAR;
            PG8_LDB(B0, 1, 0); PG8_SCHED; PG8_LDA(At, 1, 0); PG8_STAGE(PG8_SA(0, 1), a2 + hstep, voffA);
            PG8_WAIT_L(8); PG8_BAR; PG8_WAIT_L(0); PG8_MMA(0, 0, At, B0); PG8_BAR; PG8_SCHED;
            PG8_LDB(B1, 1, 1); PG8_STAGE(PG8_SB(1, 0), b3, voffB);
            PG8_BAR; PG8_WAIT_L(0); PG8_MMA(0, 1, At, B1); PG8_BAR;
            PG8_LDA(At, 1, 1); PG8_STAGE(PG8_SA(1, 0), a3, voffA);
            PG8_BAR; PG8_WAIT_L(0); PG8_MMA(1, 0, At, B0); PG8_BAR; PG8_SCHED;
            PG8_STAGE(PG8_SB(1, 1), b3 + hstep, voffB);
            PG8_WAIT_V(6); PG8_BAR; PG8_MMA(1, 1, At, B1); PG8_BAR;
        }
        E(acc, cur, wr, wc, fr, fq);
        if (!has_next) break;
#pragma unroll
        for (int a = 0; a < 2; ++a)
#pragma unroll
            for (int b = 0; b < 2; ++b)
#pragma unroll
                for (int m = 0; m < 4; ++m)
#pragma unroll
                    for (int n = 0; n < 2; ++n) acc[a][b][m][n] = (f32x4){0.f, 0.f, 0.f, 0.f};
        cur = nxt; cA = nA; cB = nB; ++ui;
    }
    PG8_WAIT_V(0);
    if (wr == 0) PG8_BAR;
    PG8_BAR;
#undef PG8_SA
#undef PG8_SB
#undef PG8_STAGE
#undef PG8_LDA
#undef PG8_LDB
#undef PG8_MMA
#undef PG8_WAIT_V
#undef PG8_WAIT_L
#undef PG8_BAR
#undef PG8_SCHED
}
}
using pg8::Unit;
typedef f32x4 AccT[2][2][4][2];

struct EpiBf16 {
    static constexpr bool PERM = true;
    bf16_t* O; int ldc; int act; int scal_pn; float* SC; const float* a_log; const float* dt_bias;
    DI void operator()(const AccT& acc, const Unit& u, int wr, int wc, int fr, int fq) const {
        const int row0 = u.pm * 256 + wr * 64 + fr;
        if (u.pn == scal_pn) {
            if (wc < 2) {
#pragma unroll
                for (int ai = 0; ai < 2; ++ai)
#pragma unroll
                    for (int m = 0; m < 4; ++m) {
                        const int row = row0 + ai * 128 + m * 16;
#pragma unroll
                        for (int n = 0; n < 2; ++n) {
                            const int c0 = 32 * wc + 8 * fq + 4 * n; const f32x4 o = acc[ai][0][m][n];
                            *(f32x4*)(SC + (size_t)row * 64 + c0) = o;
                        }
                    }
            }
            return;
        }
        const int col0 = u.pn * 256 + wc * 32 + 8 * fq;
#pragma unroll
        for (int ai = 0; ai < 2; ++ai)
#pragma unroll
            for (int m = 0; m < 4; ++m) { bf16_t* rowp = O + (size_t)(row0 + ai * 128 + m * 16) * ldc + col0;
#pragma unroll
                for (int bj = 0; bj < 2; ++bj) { f32x4 v0 = acc[ai][bj][m][0], v1 = acc[ai][bj][m][1];
                    if (act == 1) {
#pragma unroll
                        for (int j = 0; j < 4; ++j) { v0[j] = sigmoidf_(v0[j]); v1[j] = sigmoidf_(v1[j]); } }
                    u32x4 w; w.x = pk2(v0[0], v0[1]); w.y = pk2(v0[2], v0[3]); w.z = pk2(v1[0], v1[1]); w.w = pk2(v1[2], v1[3]);
                    *(u32x4*)(rowp + bj * 128) = w; } }
    }
};
struct EpiZgGate {
    static constexpr bool PERM = true;
    bf16_t* ZG; bf16_t* GATE;
    DI void operator()(const AccT& acc, const Unit& u, int wr, int wc, int fr, int fq) const {
        const int row0 = u.pm * 256 + wr * 64 + fr;
        const bool isg = u.pn >= 8;
        bf16_t* O = isg ? GATE : ZG; const int ldc = isg ? 4096 : 2048;
        const int col0 = (isg ? (u.pn - 8) : u.pn) * 256 + wc * 32 + 8 * fq;
#pragma unroll
        for (int ai = 0; ai < 2; ++ai)
#pragma unroll
            for (int m = 0; m < 4; ++m) { bf16_t* rowp = O + (size_t)(row0 + ai * 128 + m * 16) * ldc + col0;
#pragma unroll
                for (int bj = 0; bj < 2; ++bj) { f32x4 v0 = acc[ai][bj][m][0], v1 = acc[ai][bj][m][1];
                    if (isg) {
#pragma unroll
                        for (int j = 0; j < 4; ++j) { v0[j] = sigmoidf_(v0[j]); v1[j] = sigmoidf_(v1[j]); } }
                    u32x4 w; w.x = pk2(v0[0], v0[1]); w.y = pk2(v0[2], v0[3]); w.z = pk2(v1[0], v1[1]); w.w = pk2(v1[2], v1[3]);
                    *(u32x4*)(rowp + bj * 128) = w; } }
    }
};
struct EpiGateMul {
    static constexpr bool PERM = true;
    bf16_t* O; const bf16_t* add; const bf16_t* gate; int goff;
    DI void operator()(const AccT& acc, const Unit& u, int wr, int wc, int fr, int fq) const {
        const int row0 = u.pm * 256 + wr * 64 + fr, col0 = u.pn * 256 + wc * 32 + 8 * fq;
        if (!add) {
            u32x4 g2[2][4][2];
#pragma unroll
            for (int ai = 0; ai < 2; ++ai)
#pragma unroll
                for (int m = 0; m < 4; ++m)
#pragma unroll
                    for (int bj = 0; bj < 2; ++bj) g2[ai][m][bj] = *(const u32x4*)(gate + (size_t)(row0 + ai * 128 + m * 16) * 4096 + goff + col0 + bj * 128);
#pragma unroll
            for (int ai = 0; ai < 2; ++ai)
#pragma unroll
                for (int m = 0; m < 4; ++m)
#pragma unroll
                    for (int bj = 0; bj < 2; ++bj) { const u32x4 gv = g2[ai][m][bj]; const f32x4 v0 = acc[ai][bj][m][0], v1 = acc[ai][bj][m][1];
                        u32x4 w; w.x = pk2(v0[0] * bflo(gv.x), v0[1] * bfhi(gv.x)); w.y = pk2(v0[2] * bflo(gv.y), v0[3] * bfhi(gv.y));
                        w.z = pk2(v1[0] * bflo(gv.z), v1[1] * bfhi(gv.z)); w.w = pk2(v1[2] * bflo(gv.w), v1[3] * bfhi(gv.w));
                        *(u32x4*)(O + (size_t)(row0 + ai * 128 + m * 16) * 2048 + col0 + bj * 128) = w; }
            return;
        }
#pragma unroll
        for (int ai = 0; ai < 2; ++ai) {
            u32x4 gvv[4][2], avv[4][2];
#pragma unroll
            for (int m = 0; m < 4; ++m)
#pragma unroll
                for (int bj = 0; bj < 2; ++bj) { const size_t row = (size_t)(row0 + ai * 128 + m * 16); const int col = col0 + bj * 128;
                    gvv[m][bj] = *(const u32x4*)(gate + row * 4096 + goff + col);
                    avv[m][bj] = add ? *(const u32x4*)(add + row * 2048 + col) : (u32x4){0u, 0u, 0u, 0u}; }
#pragma unroll
            for (int m = 0; m < 4; ++m)
#pragma unroll
                for (int bj = 0; bj < 2; ++bj) { const size_t row = (size_t)(row0 + ai * 128 + m * 16); const int col = col0 + bj * 128;
                    const u32x4 gv = gvv[m][bj], av = avv[m][bj];
                    const f32x4 v0 = acc[ai][bj][m][0], v1 = acc[ai][bj][m][1];
                    float o[8] = { v0[0] * bflo(gv.x) + bflo(av.x), v0[1] * bfhi(gv.x) + bfhi(av.x), v0[2] * bflo(gv.y) + bflo(av.y), v0[3] * bfhi(gv.y) + bfhi(av.y),
                                   v1[0] * bflo(gv.z) + bflo(av.z), v1[1] * bfhi(gv.z) + bfhi(av.z), v1[2] * bflo(gv.w) + bflo(av.w), v1[3] * bfhi(gv.w) + bfhi(av.w) };
                    u32x4 w; w.x = pk2(o[0], o[1]); w.y = pk2(o[2], o[3]); w.z = pk2(o[4], o[5]); w.w = pk2(o[6], o[7]);
                    *(u32x4*)(O + row * 2048 + col) = w; }
            asm volatile("" ::: "memory"); }
    }
};
struct EpiResidual {
    static constexpr bool PERM = false;
    float* out; const float* res; const float* mod; int seg;
    DI void operator()(const AccT& acc, const Unit& u, int wr, int wc, int fr, int fq) const {
        const int row0 = u.pm * 256 + wr * 64 + fr, col0 = u.pn * 256 + wc * 32 + 4 * fq;
        const int b = (u.pm * 256) / SEQL;
        f32x4 gv[2][2];
#pragma unroll
        for (int bj = 0; bj < 2; ++bj)
#pragma unroll
            for (int n = 0; n < 2; ++n) gv[bj][n] = *(const f32x4*)(mod + (size_t)b * 12288 + seg * 2048 + col0 + bj * 128 + n * 16);
#pragma unroll
        for (int ai = 0; ai < 2; ++ai)
#pragma unroll
            for (int m = 0; m < 4; ++m) { const size_t off = (size_t)(row0 + ai * 128 + m * 16) * 2048 + col0;
#pragma unroll
                for (int bj = 0; bj < 2; ++bj)
#pragma unroll
                    for (int n = 0; n < 2; ++n) { const f32x4 bs = *(const f32x4*)(res + off + bj * 128 + n * 16);
                        *(f32x4*)(out + off + bj * 128 + n * 16) = bs + gv[bj][n] * acc[ai][bj][m][n]; }
                asm volatile("" ::: "memory"); }
    }
};
template <bool RESBF>
struct EpiResidualBf {
    static constexpr bool PERM = true;
    bf16_t* out; const void* res; const float* mod; int seg;
    DI void operator()(const AccT& acc, const Unit& u, int wr, int wc, int fr, int fq) const {
        const int row0 = u.pm * 256 + wr * 64 + fr, col0 = u.pn * 256 + wc * 32 + 8 * fq;
        const int b = (u.pm * 256) / SEQL;
        f32x4 gv[2][2];
#pragma unroll
        for (int bj = 0; bj < 2; ++bj)
#pragma unroll
            for (int n = 0; n < 2; ++n) gv[bj][n] = *(const f32x4*)(mod + (size_t)b * 12288 + seg * 2048 + col0 + bj * 128 + n * 4);
#pragma unroll
        for (int ai = 0; ai < 2; ++ai) {
            f32x4 rr[4][2][2];
#pragma unroll
            for (int m = 0; m < 4; ++m)
#pragma unroll
                for (int bj = 0; bj < 2; ++bj) { const size_t off = (size_t)(row0 + ai * 128 + m * 16) * 2048 + col0 + bj * 128;
                    if (RESBF) { const u32x4 q = *(const u32x4*)((const bf16_t*)res + off); rr[m][bj][0] = (f32x4){bflo(q.x), bfhi(q.x), bflo(q.y), bfhi(q.y)}; rr[m][bj][1] = (f32x4){bflo(q.z), bfhi(q.z), bflo(q.w), bfhi(q.w)}; }
                    else { rr[m][bj][0] = *(const f32x4*)((const float*)res + off); rr[m][bj][1] = *(const f32x4*)((const float*)res + off + 4); } }
#pragma unroll
            for (int m = 0; m < 4; ++m)
#pragma unroll
                for (int bj = 0; bj < 2; ++bj) { const size_t off = (size_t)(row0 + ai * 128 + m * 16) * 2048 + col0 + bj * 128;
                    const f32x4 o0 = rr[m][bj][0] + gv[bj][0] * acc[ai][bj][m][0], o1 = rr[m][bj][1] + gv[bj][1] * acc[ai][bj][m][1];
                    u32x4 w; w.x = pk2(o0[0], o0[1]); w.y = pk2(o0[2], o0[3]); w.z = pk2(o1[0], o1[1]); w.w = pk2(o1[2], o1[3]);
                    *(u32x4*)(out + off) = w; }
            asm volatile("" ::: "memory"); }
    }
};
struct EpiSwiglu {
    static constexpr bool PERM = true;
    bf16_t* U;
    DI void operator()(const AccT& acc, const Unit& u, int wr, int wc, int fr, int fq) const {
        const int row0 = u.pm * 256 + wr * 64 + fr, col0 = u.pn * 128 + wc * 32 + 8 * fq;
#pragma unroll
        for (int ai = 0; ai < 2; ++ai)
#pragma unroll
            for (int m = 0; m < 4; ++m) { float o[8];
#pragma unroll
                for (int n = 0; n < 2; ++n)
#pragma unroll
                    for (int j = 0; j < 4; ++j) o[n * 4 + j] = siluf_(acc[ai][0][m][n][j]) * acc[ai][1][m][n][j];
                u32x4 w; w.x = pk2(o[0], o[1]); w.y = pk2(o[2], o[3]); w.z = pk2(o[4], o[5]); w.w = pk2(o[6], o[7]);
                *(u32x4*)(U + (size_t)(row0 + ai * 128 + m * 16) * DFF + col0) = w; }
    }
};

DI void job_convert(const float* src, int ldsrc, int srccol0, int nvalid, bf16_t* dst, int K, int r0, int k0, LAS unsigned char* lds) {
    LAS bf16_t* T = (LAS bf16_t*)lds;
    const int tid = tidx();
    __syncthreads();
#pragma unroll
    for (int ps = 0; ps < 8; ++ps) {
        const int kk = (tid >> 5) + 16 * ps, n4 = (tid & 31) * 4;
        f32x4 v = (f32x4){0.f, 0.f, 0.f, 0.f};
        if (n4 < nvalid) v = *(const f32x4*)(src + (size_t)(k0 + kk) * ldsrc + srccol0 + n4);
#pragma unroll
        for (int j = 0; j < 4; ++j) T[(n4 + j) * 130 + kk] = f2bf(v[j]);
    }
    __syncthreads();
#pragma unroll
    for (int ps = 0; ps < 4; ++ps) {
        const int n = (tid >> 4) + 32 * ps, ks = (tid & 15) * 8;
        const LAS unsigned* sp = (const LAS unsigned*)(T + n * 130 + ks);
        u32x4 w; w.x = sp[0]; w.y = sp[1]; w.z = sp[2]; w.w = sp[3];
        *(u32x4*)(dst + (size_t)(r0 + n) * K + k0 + ks) = w;
    }
}
DI void convert_item(const float* src, int ldsrc, int K, bf16_t* dst, int item, int kind, LAS unsigned char* lds) {
    const int nkt = K / 128, rt = item / nkt, kt = item % nkt;
    int sc0 = 0, nv = 128;
    const int r0 = rt * 128;
    if (kind == 0) { sc0 = r0; }
    else if (kind == 1) {
        if (r0 < 6144) sc0 = COL_QKV + r0; else if (r0 == 6144) { sc0 = COL_SCAL; nv = 64; } else { sc0 = 0; nv = 0; } }
    else if (kind == 2) { sc0 = (r0 < 2048) ? COL_Z + r0 : COL_GATE + (r0 - 2048); }
    else if (kind == 3) { sc0 = r0; }
    else if (kind == 4) { const int pn = r0 / 256, w = r0 % 256; sc0 = (w < 128) ? pn * 128 : DFF + pn * 128; }
    job_convert(src, ldsrc, sc0, nv, dst, K, r0, kt * 128, lds);
}

DI void job_modp(const Params& p, int item, LAS unsigned char* lds) {
    LAS float* s = (LAS float*)lds;
    const int cb = item % 24, kc = item / 24, tid = tidx();
    __syncthreads();
    for (int i = tid; i < 640; i += NTHREADS) { const int v = i >> 7, kk = i & 127, k = kc * 128 + kk; const float c = v < 4 ? p.in[1][v * 2048 + k] : p.in[3][k]; s[i] = c / (1.0f + expf(-c)); }
    __syncthreads();
    const int col = cb * 512 + tid;
    float a0 = 0.f, a1 = 0.f, a2 = 0.f, a3 = 0.f, a4 = 0.f;
    const float* wp = p.in[4] + (size_t)(kc * 128) * 12288 + col;
#pragma unroll 32
    for (int kk = 0; kk < 128; ++kk) { const float w = wp[(size_t)kk * 12288]; a0 += s[kk] * w; a1 += s[128 + kk] * w; a2 += s[256 + kk] * w; a3 += s[384 + kk] * w; a4 += s[512 + kk] * w; }
    float* mp = (float*)(p.ws + OFF_MODP) + (size_t)kc * 5 * 12288 + col;
    mp[0] = a0; mp[12288] = a1; mp[2 * 12288] = a2; mp[3 * 12288] = a3; mp[4 * 12288] = a4;
}
DI void job_filt_hidden(const Params& p, int item, LAS unsigned char* lds) {
    LAS float* z = (LAS float*)lds;
    LAS float* ha = z + 8 * 36;
    LAS float* hb = ha + 8 * 64;
    const int tid = tidx(), pp = tid >> 6, j = tid & 63, pos = item * 8 + pp;
    __syncthreads();
    if (j < 33) {
        float v;
        if (j == 0) v = (float)pos / 4095.0f;
        else { const int bnd = (j - 1) & 15; const float f = 1e-4f + (float)bnd * ((15.0f - 1e-4f) / 15.0f); const float w = 6.283185307179586f * (float)pos / 4096.0f;
            v = (j <= 16) ? cosf(f * w) : -sinf(f * w); }
        z[pp * 36 + j] = v;
    }
    __syncthreads();
    const float fr = p.in[18][j];
    { float a = p.in[12][j];
#pragma unroll 3
        for (int i = 0; i < 33; ++i) a += z[pp * 36 + i] * p.in[11][i * 64 + j]; ha[pp * 64 + j] = sinf(fr * a); }
    __syncthreads();
    { float a = p.in[14][j];
#pragma unroll 4
        for (int i = 0; i < 64; ++i) a += ha[pp * 64 + i] * p.in[13][i * 64 + j]; hb[pp * 64 + j] = sinf(fr * a); }
    __syncthreads();
    { float a = p.in[16][j];
#pragma unroll 4
        for (int i = 0; i < 64; ++i) a += hb[pp * 64 + i] * p.in[15][i * 64 + j]; ((float*)(p.ws + OFF_H3))[(size_t)pos * 64 + j] = sinf(fr * a); }
}
DI void job_taps(const Params& p, int item, LAS unsigned char* lds) {
    LAS float* h3 = (LAS float*)lds;
    const int tid = tidx(), tb = item >> 3, jb = item & 7;
    __syncthreads();
    for (int i = tid; i < 4096; i += NTHREADS) h3[i] = ((const float*)(p.ws + OFF_H3))[(size_t)tb * 4096 + i];
    __syncthreads();
    const int col = jb * 512 + tid, dir = col >> 11, c = col & 2047;
    float fo[64];
#pragma unroll
    for (int i = 0; i < 64; ++i) fo[i] = p.in[17][(size_t)i * 4096 + col];
    const float dmin = -3.0701134573253944f, dmax = -15.350567286626973f;
    const float delta = fabsf(dmin + (float)c * ((dmax - dmin) / 2047.0f));
    bf16_t* tp = (bf16_t*)(p.ws + OFF_TAPS) + ((size_t)c * 2 + dir) * 4096 + tb * 64;
    for (int g8 = 0; g8 < 8; ++g8) {
        float v[8];
#pragma unroll
        for (int e = 0; e < 8; ++e) { const int pl = g8 * 8 + e; float a = 0.f;
#pragma unroll
            for (int i = 0; i < 64; i += 4) { const f32x4 hv = *(const LAS f32x4*)(h3 + pl * 64 + i); a += hv[0] * fo[i] + hv[1] * fo[i + 1] + hv[2] * fo[i + 2] + hv[3] * fo[i + 3]; }
            const float t = (float)(tb * 64 + pl) / 4095.0f; v[e] = a * expf(-t * delta); }
        u32x4 w; w.x = pk2(v[0], v[1]); w.y = pk2(v[2], v[3]); w.z = pk2(v[4], v[5]); w.w = pk2(v[6], v[7]);
        *(u32x4*)(tp + g8 * 8) = w;
    }
}
DI void job_taps_mfma(const Params& p, int witem) {
    const int lane = tidx() & 63, r = lane & 31, hh = lane >> 5;
    const int cbk = witem >> 4, pc = witem & 15;
    const float* fout = p.in[17]; const float* h3 = (const float*)(p.ws + OFF_H3);
    bf16x8 af[4];
#pragma unroll
    for (int ks = 0; ks < 4; ++ks) { float f[8];
#pragma unroll
        for (int j = 0; j < 8; ++j) f[j] = fout[(size_t)(16 * ks + 8 * hh + j) * 4096 + cbk * 32 + r];
        u32x4 q; q.x = pk2(f[0], f[1]); q.y = pk2(f[2], f[3]); q.z = pk2(f[4], f[5]); q.w = pk2(f[6], f[7]); af[ks] = __builtin_bit_cast(bf16x8, q); }
    const float dmin = -3.0701134573253944f, dmax = -15.350567286626973f;
    bf16_t* TP = (bf16_t*)(p.ws + OFF_TAPS);
#pragma unroll 1
    for (int pb = 0; pb < 8; ++pb) {
        const int pos = pc * 256 + pb * 32 + r;
        f32x16 acc;
#pragma unroll
        for (int i = 0; i < 16; ++i) acc[i] = 0.f;
#pragma unroll
        for (int ks = 0; ks < 4; ++ks) { const f32x4 h0 = *(const f32x4*)(h3 + (size_t)pos * 64 + 16 * ks + 8 * hh), h1 = *(const f32x4*)(h3 + (size_t)pos * 64 + 16 * ks + 8 * hh + 4);
            u32x4 q; q.x = pk2(h0[0], h0[1]); q.y = pk2(h0[2], h0[3]); q.z = pk2(h1[0], h1[1]); q.w = pk2(h1[2], h1[3]);
            acc = MFMA32(af[ks], __builtin_bit_cast(bf16x8, q), acc); }
        const float t = (float)pos / 4095.0f;
#pragma unroll
        for (int i = 0; i < 16; ++i) { const int col = cbk * 32 + crow(i, hh), dir = col >> 11, c = col & 2047;
            const float delta = fabsf(dmin + (float)c * ((dmax - dmin) / 2047.0f));
            TP[((size_t)c * 2 + dir) * 4096 + pos] = f2bf(acc[i] * __expf(-t * delta)); }
    }
}
template <bool XBF>
DI void job_hrows(const void* Xv, const float* nw, const float* modsrc, int npart, const float* bias, int v, int seg_sh, int seg_sc, bf16_t* Hout, LAS unsigned char* lds) {
    LAS float* mul = (LAS float*)lds;
    LAS float* sh = mul + 2048;
    const int tid = tidx(), lane = tid & 63, w = tid >> 6;
    __syncthreads();
    for (int k = tid; k < 2048; k += NTHREADS) {
        float sc = bias ? bias[seg_sc * 2048 + k] : 0.f, s2 = bias ? bias[seg_sh * 2048 + k] : 0.f;
        for (int pt = 0; pt < npart; ++pt) { const float* mp = modsrc + ((size_t)pt * 5 + v) * 12288; sc += mp[seg_sc * 2048 + k]; s2 += mp[seg_sh * 2048 + k]; }
        mul[k] = nw[k] * (1.0f + sc); sh[k] = s2;
    }
    __syncthreads();
    for (int rr = w; rr < 64; rr += 8) {
        f32x4 xv[8]; float ss = 0.f;
#pragma unroll
        for (int i = 0; i < 8; ++i) {
            if (XBF) { const u32x2 q = *(const u32x2*)((const bf16_t*)Xv + (size_t)rr * 2048 + (i * 64 + lane) * 4); xv[i] = (f32x4){bflo(q.x), bfhi(q.x), bflo(q.y), bfhi(q.y)}; }
            else xv[i] = *(const f32x4*)((const float*)Xv + (size_t)rr * 2048 + (i * 64 + lane) * 4);
            ss += xv[i][0] * xv[i][0] + xv[i][1] * xv[i][1] + xv[i][2] * xv[i][2] + xv[i][3] * xv[i][3]; }
        ss = wave_sum(ss);
        const float rstd = 1.0f / sqrtf(ss * (1.0f / 2048.0f) + 1e-6f);
#pragma unroll
        for (int i = 0; i < 8; ++i) { const int k = (i * 64 + lane) * 4; const f32x4 mv = *(const LAS f32x4*)(mul + k), sv = *(const LAS f32x4*)(sh + k);
            u32x2 o; o.x = pk2(xv[i][0] * rstd * mv[0] + sv[0], xv[i][1] * rstd * mv[1] + sv[1]); o.y = pk2(xv[i][2] * rstd * mv[2] + sv[2], xv[i][3] * rstd * mv[3] + sv[3]);
            *(u32x2*)(Hout + (size_t)rr * 2048 + k) = o; }
    }
}
DI void job_hyconv(const Params& p, int item, LAS unsigned char* lds) {
    LAS bf16_t* X0 = (LAS bf16_t*)lds;
    LAS bf16_t* ZT = X0 + 3 * 64 * 136;
    const int tid = tidx(), rr = item >> 4, cb = item & 15, c0 = cb * 128;
    bf16_t* P = (bf16_t*)(p.ws + OFF_X) + (size_t)rr * 64 * 6144;
    const float* cw = p.in[9];
    __syncthreads();
#pragma unroll
    for (int ps = 0; ps < 6; ++ps) { const int e = tid + ps * NTHREADS, part = e >> 10, tok = (e >> 4) & 63, seg = e & 15;
        *(LAS u32x4*)(X0 + part * 64 * 136 + tok * 136 + seg * 8) = *(const u32x4*)(P + (size_t)tok * 6144 + part * 2048 + c0 + seg * 8); }
    __syncthreads();
#pragma unroll
    for (int ps = 0; ps < 2; ++ps) { const int tok = (tid >> 4) + 32 * ps, seg = tid & 15;
        float r[3][8];
#pragma unroll
        for (int part = 0; part < 3; ++part) {
            const LAS bf16_t* base = X0 + part * 64 * 136 + tok * 136 + seg * 8;
            const u32x4 cur = *(const LAS u32x4*)base;
            u32x4 prv = (u32x4){0u, 0u, 0u, 0u}, nxt = (u32x4){0u, 0u, 0u, 0u};
            if (tok > 0) prv = *(const LAS u32x4*)(base - 136);
            if (tok < 63) nxt = *(const LAS u32x4*)(base + 136);
            const float* w0 = cw + part * 2048 + c0 + seg * 8;
            const unsigned pw[4] = {prv.x, prv.y, prv.z, prv.w}, cwd[4] = {cur.x, cur.y, cur.z, cur.w}, nw[4] = {nxt.x, nxt.y, nxt.z, nxt.w};
#pragma unroll
            for (int q = 0; q < 4; ++q) {
                r[part][2 * q] = bflo(pw[q]) * w0[2 * q] + bflo(cwd[q]) * w0[6144 + 2 * q] + bflo(nw[q]) * w0[12288 + 2 * q];
                r[part][2 * q + 1] = bfhi(pw[q]) * w0[2 * q + 1] + bfhi(cwd[q]) * w0[6144 + 2 * q + 1] + bfhi(nw[q]) * w0[12288 + 2 * q + 1]; }
        }
        u32x4 w; w.x = pk2(r[0][0], r[0][1]); w.y = pk2(r[0][2], r[0][3]); w.z = pk2(r[0][4], r[0][5]); w.w = pk2(r[0][6], r[0][7]);
        *(u32x4*)(P + (size_t)tok * 6144 + c0 + seg * 8) = w;
#pragma unroll
        for (int e = 0; e < 8; ++e) ZT[(seg * 8 + e) * 72 + tok] = f2bf(r[1][e] * r[2][e]);
    }
    __syncthreads();
    const int b = rr >> 6, t0 = (rr & 63) * 64;
    bf16_t* zT = (bf16_t*)(p.ws + OFF_BIG);
#pragma unroll
    for (int ps = 0; ps < 2; ++ps) { const int ch = (tid >> 3) + 64 * ps, ts = (tid & 7) * 8;
        *(u32x4*)(zT + ((size_t)(c0 + ch) * 4 + b) * 4096 + t0 + ts) = *(const LAS u32x4*)(ZT + ch * 72 + ts); }
}
DI void hyconv_pipe(const Params& p, LAS unsigned char* lds, int bid, int G) {
    LAS bf16_t* X0 = (LAS bf16_t*)lds;
    LAS bf16_t* ZT = X0 + 3 * 64 * 136;
    const int tid = tidx(), seg = tid & 15, tk0 = tid >> 4;
    int u = bid; if (u >= 4096) return;
    bf16_t* Pb = (bf16_t*)(p.ws + OFF_X);
    bf16_t* zT = (bf16_t*)(p.ws + OFF_BIG);
    u32x4 pa[6], pb[6];
#define HY_LOAD(dst, it) do { const bf16_t* P_ = Pb + (size_t)((it) >> 4) * 64 * 6144 + ((it) & 15) * 128; \
        _Pragma("unroll") for (int part = 0; part < 3; ++part) _Pragma("unroll") for (int ps = 0; ps < 2; ++ps) \
            dst[part * 2 + ps] = *(const u32x4*)(P_ + (size_t)(tk0 + 32 * ps) * 6144 + part * 2048 + seg * 8); } while (0)
    HY_LOAD(pa, u);
    if (u + G < 4096) HY_LOAD(pb, u + G);
    __syncthreads();
    for (;;) {
        const int rr = u >> 4, c0 = (u & 15) * 128;
        bf16_t* P = Pb + (size_t)rr * 64 * 6144;
        f32x4 wv[3][3][2];
#pragma unroll
        for (int part = 0; part < 3; ++part)
#pragma unroll
            for (int k = 0; k < 3; ++k) { const float* wp = p.in[9] + k * 6144 + part * 2048 + c0 + seg * 8; wv[part][k][0] = *(const f32x4*)wp; wv[part][k][1] = *(const f32x4*)(wp + 4); }
        LDS_BARRIER();
#pragma unroll
        for (int part = 0; part < 3; ++part)
#pragma unroll
            for (int ps = 0; ps < 2; ++ps) { *(LAS u32x4*)(X0 + part * 64 * 136 + (tk0 + 32 * ps) * 136 + seg * 8) = pa[part * 2 + ps]; pa[part * 2 + ps] = pb[part * 2 + ps]; }
        if (u + 2 * G < 4096) HY_LOAD(pb, u + 2 * G);
        LDS_BARRIER();
#pragma unroll
        for (int ps = 0; ps < 2; ++ps) { const int tok = tk0 + 32 * ps;
            float r[3][8];
#pragma unroll
            for (int part = 0; part < 3; ++part) {
                const LAS bf16_t* base = X0 + part * 64 * 136 + tok * 136 + seg * 8;
                const u32x4 cur = *(const LAS u32x4*)base;
                u32x4 prv = (u32x4){0u, 0u, 0u, 0u}, nxt = (u32x4){0u, 0u, 0u, 0u};
                if (tok > 0) prv = *(const LAS u32x4*)(base - 136);
                if (tok < 63) nxt = *(const LAS u32x4*)(base + 136);
                const unsigned pw[4] = {prv.x, prv.y, prv.z, prv.w}, cwd[4] = {cur.x, cur.y, cur.z, cur.w}, nw[4] = {nxt.x, nxt.y, nxt.z, nxt.w};
#pragma unroll
                for (int q = 0; q < 4; ++q) { const int h2 = q >> 1, e0 = (2 * q) & 3;
                    r[part][2 * q] = bflo(pw[q]) * wv[part][0][h2][e0] + bflo(cwd[q]) * wv[part][1][h2][e0] + bflo(nw[q]) * wv[part][2][h2][e0];
                    r[part][2 * q + 1] = bfhi(pw[q]) * wv[part][0][h2][e0 + 1] + bfhi(cwd[q]) * wv[part][1][h2][e0 + 1] + bfhi(nw[q]) * wv[part][2][h2][e0 + 1]; }
            }
            u32x4 w; w.x = pk2(r[0][0], r[0][1]); w.y = pk2(r[0][2], r[0][3]); w.z = pk2(r[0][4], r[0][5]); w.w = pk2(r[0][6], r[0][7]);
            *(u32x4*)(P + (size_t)tok * 6144 + c0 + seg * 8) = w;
            const int tsw = (((tok >> 2) ^ seg) << 2) + (tok & 3);
#pragma unroll
            for (int e = 0; e < 8; ++e) ZT[(seg * 8 + e) * 72 + tsw] = f2bf(r[1][e] * r[2][e]);
        }
        LDS_BARRIER();
        const int b = rr >> 6, t0 = (rr & 63) * 64;
#pragma unroll
        for (int ps = 0; ps < 2; ++ps) { const int ch = (tid >> 3) + 64 * ps, tsb = tid & 7, sg = ch >> 3;
            const u32x4 v = *(const LAS u32x4*)(ZT + ch * 72 + ((tsb ^ (sg >> 1)) << 3));
            const u32x4 o = (sg & 1) ? (u32x4){v.z, v.w, v.x, v.y} : v;
            *(u32x4*)(zT + ((size_t)(c0 + ch) * 4 + b) * 4096 + t0 + tsb * 8) = o; }
        u += G;
        if (u >= 4096) break;
    }
#undef HY_LOAD
    __syncthreads();
}
constexpr int LC_ZB = 6336, LC_ZP = 80;
constexpr int LC_Q = 0, LC_ZS = 65536, LC_G = LC_ZS + 4 * LC_ZB * 2, LC_END = LC_G + 8200 * 2;
DI void longconv_init(LAS unsigned char* lds) {
    LAS bf16_t* ZS = (LAS bf16_t*)(lds + LC_ZS);
    LAS bf16_t* Gt = (LAS bf16_t*)(lds + LC_G);
    __syncthreads();
    for (int i = tidx(); i < 4 * LC_ZB; i += NTHREADS) ZS[i] = 0;
    if (tidx() < 8) { Gt[8192 + tidx()] = 0; }
    if (tidx() == 8) Gt[0] = 0;
    __syncthreads();
}
DI void lds_rd64(u32x2& d, unsigned addr) { asm volatile("ds_read_b64 %0, %1" : "=v"(d) : "v"(addr)); }
DI void lds_rd64o(u32x2& d, unsigned addr) { asm volatile("ds_read_b64 %0, %1 offset:32" : "=v"(d) : "v"(addr)); }
DI void lds_rd128(u32x4& d, unsigned addr, int) { asm volatile("ds_read_b128 %0, %1" : "=v"(d) : "v"(addr)); }
struct LcFrags { u32x2 a[6][2]; u32x4 b[4]; };
DI void lc_load(LcFrags& f, unsigned qaddr, unsigned baddr) {
#pragma unroll
    for (int i = 0; i < 6; ++i) { lds_rd64(f.a[i][0], qaddr + (unsigned)(16 * i - 48) * 8u); lds_rd64o(f.a[i][1], qaddr + (unsigned)(16 * i - 48) * 8u); }
#pragma unroll
    for (int lb2 = 0; lb2 < 2; ++lb2)
#pragma unroll
        for (int cg = 0; cg < 2; ++cg) lds_rd128(f.b[lb2 * 2 + cg], baddr + 64u * lb2 + (unsigned)(cg * 4 * LC_ZP * 2), 0);
}
DI void lc_wait(LcFrags& f) {
    asm volatile("s_waitcnt lgkmcnt(0)" : "+v"(f.a[0][0]), "+v"(f.a[0][1]), "+v"(f.a[1][0]), "+v"(f.a[1][1]), "+v"(f.a[2][0]), "+v"(f.a[2][1]),
                 "+v"(f.a[3][0]), "+v"(f.a[3][1]), "+v"(f.a[4][0]), "+v"(f.a[4][1]), "+v"(f.a[5][0]), "+v"(f.a[5][1]) :: "memory");
    asm volatile("" : "+v"(f.b[0]), "+v"(f.b[1]), "+v"(f.b[2]), "+v"(f.b[3]) :: "memory");
}
DI bf16x8 lc_a(const LcFrags& f, int i) { union { u32x2 h[2]; bf16x8 v; } u; u.h[0] = f.a[i][0]; u.h[1] = f.a[i][1]; return u.v; }
DI void longconv_pipe(const Params& p, LAS unsigned char* lds, int bid, int G) {
    LAS unsigned long long* Q = (LAS unsigned long long*)(lds + LC_Q);
    LAS bf16_t* ZS = (LAS bf16_t*)(lds + LC_ZS);
    LAS bf16_t* Gt = (LAS bf16_t*)(lds + LC_G);
    const int tid = tidx(), lane = tid & 63, w = tid >> 6;
    int c = bid; if (c >= 2048) return;
    u32x4 ptf, ptb, pz[4]; float pbias;
#define LC_PREFETCH(cc) do { const bf16_t* tp_ = (const bf16_t*)(p.ws + OFF_TAPS) + (size_t)(cc) * 8192; const bf16_t* zp_ = (const bf16_t*)(p.ws + OFF_BIG) + (size_t)(cc) * 4 * 4096; \
        ptf = *(const u32x4*)(tp_ + tid * 8); ptb = *(const u32x4*)(tp_ + 4096 + tid * 8); pbias = p.in[10][(cc)]; \
        _Pragma("unroll") for (int ps = 0; ps < 4; ++ps) { const int e_ = tid + ps * NTHREADS; pz[ps] = *(const u32x4*)(zp_ + (size_t)(e_ >> 9) * 4096 + (e_ & 511) * 8); } } while (0)
    LC_PREFETCH(c);
    __syncthreads();
  for (;;) {
    const float bias = pbias;
    LDS_BARRIER();
    {
        const u32x4 tf = ptf;
        u32x4 tb = ptb;
        if (tid == 0) tb.x = (tb.x & 0xffff0000u) | (tf.x & 0xffffu);
        *(LAS u32x4*)(Gt + 4096 + tid * 8) = tb;
        const unsigned fw[4] = {tf.x, tf.y, tf.z, tf.w};
#pragma unroll
        for (int q = 0; q < 4; ++q) { if (tid > 0 || q > 0) Gt[4096 - (tid * 8 + 2 * q)] = (bf16_t)(fw[q] & 0xffffu); Gt[4096 - (tid * 8 + 2 * q + 1)] = (bf16_t)(fw[q] >> 16); }
    }
#pragma unroll
    for (int ps = 0; ps < 4; ++ps) { const int e = tid + ps * NTHREADS, b = e >> 9, s = (e & 511) * 8, k = s >> 6, l = s & 63;
        *(LAS u32x4*)(ZS + b * LC_ZB + (k + 7) * LC_ZP + l) = pz[ps]; }
    if (c + G < 2048) LC_PREFETCH(c + G);
    LDS_BARRIER();
#pragma unroll
    for (int ps = 0; ps < 4; ++ps) { const int m = tid + ps * NTHREADS;
        const unsigned long long lo = *(const LAS unsigned long long*)(Gt + 4 * m), hi = *(const LAS unsigned long long*)(Gt + 4 * m + 4);
        Q[4 * m] = lo; Q[4 * m + 1] = (lo >> 16) | (hi << 48); Q[4 * m + 2] = (lo >> 32) | (hi << 32); Q[4 * m + 3] = (lo >> 48) | (hi << 16); }
    LDS_BARRIER();
    const int r16 = lane & 15, q4 = lane >> 4, nb = r16 >> 2, ni = r16 & 3, i0 = 8 * w;
    f32x4 acc[4][2];
#pragma unroll
    for (int jb = 0; jb < 4; ++jb)
#pragma unroll
        for (int cg = 0; cg < 2; ++cg) acc[jb][cg] = (f32x4){0.f, 0.f, 0.f, 0.f};
    const int dlo = i0 - 63, dhi = i0 + 7;
    unsigned qaddr = (unsigned)(LC_Q + (4096 - 64 * dlo - r16 + 8 * q4) * 8);
    unsigned baddr = (unsigned)(LC_ZS + (nb * LC_ZB + (i0 + ni - dlo + 7) * LC_ZP + 8 * q4) * 2);
    LcFrags fa, fb;
    lc_load(fa, qaddr, baddr);
#define LC_STEP(cur, nxt, more, C0, C1) do { \
        lc_wait(cur); \
        qaddr -= 512u; baddr -= (unsigned)(LC_ZP * 2); \
        if (more) lc_load(nxt, qaddr, baddr); \
        _Pragma("unroll") for (int lb2 = 0; lb2 < 2; ++lb2) _Pragma("unroll") for (int jb = 0; jb < 4; ++jb) _Pragma("unroll") for (int cg = 0; cg < 2; ++cg) \
            if ((cg == 0 && (C0)) || (cg == 1 && (C1))) \
                acc[jb][cg] = __builtin_amdgcn_mfma_f32_16x16x32_bf16(lc_a(cur, 3 - jb + 2 * lb2), __builtin_bit_cast(bf16x8, cur.b[lb2 * 2 + cg]), acc[jb][cg], 0, 0, 0); } while (0)
    LC_STEP(fa, fb, true, true, false); LC_STEP(fb, fa, true, true, false); LC_STEP(fa, fb, true, true, false); LC_STEP(fb, fa, true, true, false);
#pragma unroll 1
    for (int it = 0; it < 31; ++it) { LC_STEP(fa, fb, true, true, true); LC_STEP(fb, fa, true, true, true); }
    LC_STEP(fa, fb, true, true, true);
    LC_STEP(fb, fa, true, false, true); LC_STEP(fa, fb, true, false, true); LC_STEP(fb, fa, true, false, true); LC_STEP(fa, fb, false, false, true);
#undef LC_STEP
#pragma unroll
    for (int cg = 0; cg < 2; ++cg) { const int ib = i0 + 4 * cg + ni;
        bf16_t* yT = (bf16_t*)(p.ws + OFF_BIG + SZ67) + ((size_t)c * 4 + nb) * 4096 + 64 * ib;
        const LAS bf16_t* zrow = ZS + nb * LC_ZB + (ib + 7) * LC_ZP;
#pragma unroll
        for (int jb = 0; jb < 4; ++jb) { const int j = 16 * jb + 4 * q4; float o[4];
#pragma unroll
            for (int e = 0; e < 4; ++e) o[e] = acc[jb][cg][e] + bias * bf2f(zrow[j + e]);
            u32x2 wv; wv.x = pk2(o[0], o[1]); wv.y = pk2(o[2], o[3]);
            *(u32x2*)(yT + j) = wv; } }
    c += G; if (c >= 2048) break;
  }
#undef LC_PREFETCH
    __syncthreads();
}
DI void job_hmix(const Params& p, int item, LAS unsigned char* lds) {
    LAS bf16_t* T = (LAS bf16_t*)lds;
    const int tid = tidx(), rr = item >> 4, cb = item & 15, c0 = cb * 128, b = rr >> 6, t0 = (rr & 63) * 64;
    const bf16_t* yT = (const bf16_t*)(p.ws + OFF_BIG + SZ67);
    __syncthreads();
#pragma unroll
    for (int ps = 0; ps < 2; ++ps) { const int ch = (tid >> 3) + 64 * ps, ts = (tid & 7) * 8;
        const u32x4 v = *(const u32x4*)(yT + ((size_t)(c0 + ch) * 4 + b) * 4096 + t0 + ts);
        LAS unsigned* dp = (LAS unsigned*)(T + ch * 66 + ts); dp[0] = v.x; dp[1] = v.y; dp[2] = v.z; dp[3] = v.w; }
    __syncthreads();
    const bf16_t* P = (const bf16_t*)(p.ws + OFF_X) + (size_t)rr * 64 * 6144;
    bf16_t* HM = (bf16_t*)(p.ws + OFF_BIG + 2 * SZ67) + (size_t)rr * 64 * 2048;
#pragma unroll
    for (int ps = 0; ps < 2; ++ps) { const int tok = (tid >> 4) + 32 * ps, seg = tid & 15;
        const u32x4 xv = *(const u32x4*)(P + (size_t)tok * 6144 + c0 + seg * 8);
        float y[8];
#pragma unroll
        for (int e = 0; e < 8; ++e) y[e] = bf2f(T[(seg * 8 + e) * 66 + tok]);
        u32x4 w; w.x = pk2(bflo(xv.x) * y[0], bfhi(xv.x) * y[1]); w.y = pk2(bflo(xv.y) * y[2], bfhi(xv.y) * y[3]);
        w.z = pk2(bflo(xv.z) * y[4], bfhi(xv.z) * y[5]); w.w = pk2(bflo(xv.w) * y[6], bfhi(xv.w) * y[7]);
        *(u32x4*)(HM + (size_t)tok * 2048 + c0 + seg * 8) = w; }
}
DI void hmix_pipe(const Params& p, LAS unsigned char* lds, int bid, int G) {
    LAS bf16_t* T = (LAS bf16_t*)lds;
    const int tid = tidx(), seg = tid & 15, tk0 = tid >> 4;
    int u = bid; if (u >= 4096) return;
    const bf16_t* yT = (const bf16_t*)(p.ws + OFF_BIG + SZ67);
    const bf16_t* Pb = (const bf16_t*)(p.ws + OFF_X);
    bf16_t* HMb = (bf16_t*)(p.ws + OFF_BIG + 2 * SZ67);
    u32x4 ya[2], yb[2], xa[2], xb[2];
#define HM_LOAD(Y, X, it) do { const int rr_ = (it) >> 4, c0_ = ((it) & 15) * 128, b_ = rr_ >> 6, t0_ = (rr_ & 63) * 64; \
        _Pragma("unroll") for (int ps = 0; ps < 2; ++ps) { const int ch_ = (tid >> 3) + 64 * ps; \
            Y[ps] = *(const u32x4*)(yT + ((size_t)(c0_ + ch_) * 4 + b_) * 4096 + t0_ + (tid & 7) * 8); \
            X[ps] = *(const u32x4*)(Pb + ((size_t)rr_ * 64 + tk0 + 32 * ps) * 6144 + c0_ + seg * 8); } } while (0)
    HM_LOAD(ya, xa, u);
    if (u + G < 4096) HM_LOAD(yb, xb, u + G);
    __syncthreads();
    for (;;) {
        const int rr = u >> 4, c0 = (u & 15) * 128;
        LDS_BARRIER();
        u32x4 xc[2];
#pragma unroll
        for (int ps = 0; ps < 2; ++ps) { const int ch = (tid >> 3) + 64 * ps, tsb = tid & 7, sg = ch >> 3;
            const u32x4 v = ya[ps]; const u32x4 o = (sg & 1) ? (u32x4){v.z, v.w, v.x, v.y} : v;
            *(LAS u32x4*)(T + ch * 72 + ((tsb ^ (sg >> 1)) << 3)) = o;
            xc[ps] = xa[ps]; ya[ps] = yb[ps]; xa[ps] = xb[ps]; }
        if (u + 2 * G < 4096) HM_LOAD(yb, xb, u + 2 * G);
        LDS_BARRIER();
#pragma unroll
        for (int ps = 0; ps < 2; ++ps) { const int tok = tk0 + 32 * ps;
            const u32x4 xv = xc[ps];
            const int tsw = (((tok >> 2) ^ seg) << 2) + (tok & 3);
            float y[8];
#pragma unroll
            for (int e = 0; e < 8; ++e) y[e] = bf2f(T[(seg * 8 + e) * 72 + tsw]);
            u32x4 w; w.x = pk2(bflo(xv.x) * y[0], bfhi(xv.x) * y[1]); w.y = pk2(bflo(xv.y) * y[2], bfhi(xv.y) * y[3]);
            w.z = pk2(bflo(xv.z) * y[4], bfhi(xv.z) * y[5]); w.w = pk2(bflo(xv.w) * y[6], bfhi(xv.w) * y[7]);
            *(u32x4*)(HMb + ((size_t)rr * 64 + tok) * 2048 + c0 + seg * 8) = w; }
        u += G;
        if (u >= 4096) break;
    }
#undef HM_LOAD
    __syncthreads();
}
DI void job_scal(const Params& p, int item) {
    float* SC = (float*)(p.ws + OFF_SC) + (size_t)item * 2048 + tidx() * 4;
    const int c0 = (tidx() * 4) & 63;
    f32x4 v = *(const f32x4*)SC;
#pragma unroll
    for (int j = 0; j < 4; ++j) { const int c = c0 + j; const float x = v[j];
        if (c < 32) v[j] = 1.0f / (1.0f + expf(-x));
        else { const float y = x + p.in[21][c - 32]; const float sp = fmaxf(y, 0.f) + log1pf(expf(-fabsf(y))); v[j] = -expf(p.in[20][c - 32]) * sp; } }
    *(f32x4*)SC = v;
}
DI void job_qkvconv(const Params& p, int item, LAS unsigned char* lds) {
    LAS bf16_t* T = (LAS bf16_t*)lds;
    const int tid = tidx();
    int row0, ntok, cbk;
    if (item < 12288) { row0 = (item / 48) * 64; ntok = 64; cbk = item % 48; }
    else { const int it = item - 12288; row0 = NTOK + (it / 48) * 256; ntok = 256; cbk = it % 48; }
    bf16_t* P = (bf16_t*)(p.ws + OFF_BIG) + (size_t)row0 * 6144 + cbk * 128;
    const float* cw = p.in[19] + cbk * 128;
    __syncthreads();
    for (int e = tid; e < ntok * 16; e += NTHREADS) { const int tok = e >> 4, seg = e & 15; *(LAS u32x4*)(T + tok * 136 + seg * 8) = *(const u32x4*)(P + (size_t)tok * 6144 + seg * 8); }
    __syncthreads();
    for (int e = tid; e < ntok * 16; e += NTHREADS) { const int tok = e >> 4, seg = e & 15;
        const LAS bf16_t* base = T + tok * 136 + seg * 8;
        const u32x4 cur = *(const LAS u32x4*)base;
        u32x4 prv = (u32x4){0u, 0u, 0u, 0u}, nxt = (u32x4){0u, 0u, 0u, 0u};
        if (tok > 0) prv = *(const LAS u32x4*)(base - 136);
        if (tok < ntok - 1) nxt = *(const LAS u32x4*)(base + 136);
        const float* w0 = cw + seg * 8;
        const unsigned pw[4] = {prv.x, prv.y, prv.z, prv.w}, cwd[4] = {cur.x, cur.y, cur.z, cur.w}, nw[4] = {nxt.x, nxt.y, nxt.z, nxt.w};
        float r[8]; float ss = 0.f;
#pragma unroll
        for (int q = 0; q < 4; ++q) {
            float a = bflo(pw[q]) * w0[2 * q] + bflo(cwd[q]) * w0[6144 + 2 * q] + bflo(nw[q]) * w0[12288 + 2 * q];
            float bq = bfhi(pw[q]) * w0[2 * q + 1] + bfhi(cwd[q]) * w0[6144 + 2 * q + 1] + bfhi(nw[q]) * w0[12288 + 2 * q + 1];
            a = siluf_(a); bq = siluf_(bq); r[2 * q] = a; r[2 * q + 1] = bq; ss += a * a + bq * bq; }
        if (cbk < 32) {
            ss += __shfl_xor(ss, 1); ss += __shfl_xor(ss, 2); ss += __shfl_xor(ss, 4); ss += __shfl_xor(ss, 8);
            const float sc = __builtin_amdgcn_rsqf(ss + 1e-6f);
#pragma unroll
            for (int q = 0; q < 8; ++q) r[q] *= sc; }
        u32x4 w; w.x = pk2(r[0], r[1]); w.y = pk2(r[2], r[3]); w.z = pk2(r[4], r[5]); w.w = pk2(r[6], r[7]);
        *(u32x4*)(P + (size_t)tok * 6144 + seg * 8) = w; }
}
DI void qkvconv_latent_pipe(const Params& p, LAS unsigned char* lds, int bid, int G) {
    LAS bf16_t* T = (LAS bf16_t*)lds;
    const int tid = tidx(), seg = tid & 15, tk0 = tid >> 4;
    int u = bid; if (u >= 12288) return;
    bf16_t* Pb = (bf16_t*)(p.ws + OFF_BIG);
    u32x4 pa[2], pb[2];
#define QKV_ITEM_PTR(it) (Pb + (size_t)((it) / 48) * 64 * 6144 + ((it) % 48) * 128)
#define QKV_LOAD(dst, it) do { const bf16_t* P_ = QKV_ITEM_PTR(it); _Pragma("unroll") for (int ps = 0; ps < 2; ++ps) dst[ps] = *(const u32x4*)(P_ + (size_t)(tk0 + 32 * ps) * 6144 + seg * 8); } while (0)
    QKV_LOAD(pa, u);
    if (u + G < 12288) QKV_LOAD(pb, u + G);
    __syncthreads();
    for (;;) {
        const int cbk = u % 48;
        bf16_t* P = QKV_ITEM_PTR(u);
        f32x4 wv[3][2];
#pragma unroll
        for (int k = 0; k < 3; ++k) { wv[k][0] = *(const f32x4*)(p.in[19] + k * 6144 + cbk * 128 + seg * 8); wv[k][1] = *(const f32x4*)(p.in[19] + k * 6144 + cbk * 128 + seg * 8 + 4); }
        LDS_BARRIER();
#pragma unroll
        for (int ps = 0; ps < 2; ++ps) { *(LAS u32x4*)(T + (tk0 + 32 * ps) * 136 + seg * 8) = pa[ps]; pa[ps] = pb[ps]; }
        if (u + 2 * G < 12288) QKV_LOAD(pb, u + 2 * G);
        LDS_BARRIER();
#pragma unroll
        for (int ps = 0; ps < 2; ++ps) { const int tok = tk0 + 32 * ps;
            const LAS bf16_t* base = T + tok * 136 + seg * 8;
            const u32x4 cur = *(const LAS u32x4*)base;
            u32x4 prv = (u32x4){0u, 0u, 0u, 0u}, nxt = (u32x4){0u, 0u, 0u, 0u};
            if (tok > 0) prv = *(const LAS u32x4*)(base - 136);
            if (tok < 63) nxt = *(const LAS u32x4*)(base + 136);
            const unsigned pw[4] = {prv.x, prv.y, prv.z, prv.w}, cwd[4] = {cur.x, cur.y, cur.z, cur.w}, nw[4] = {nxt.x, nxt.y, nxt.z, nxt.w};
            float r[8]; float ss = 0.f;
#pragma unroll
            for (int q = 0; q < 4; ++q) { const int h2 = q >> 1, e0 = (2 * q) & 3;
                float a = bflo(pw[q]) * wv[0][h2][e0] + bflo(cwd[q]) * wv[1][h2][e0] + bflo(nw[q]) * wv[2][h2][e0];
                float bq = bfhi(pw[q]) * wv[0][h2][e0 + 1] + bfhi(cwd[q]) * wv[1][h2][e0 + 1] + bfhi(nw[q]) * wv[2][h2][e0 + 1];
                a = siluf_(a); bq = siluf_(bq); r[2 * q] = a; r[2 * q + 1] = bq; ss += a * a + bq * bq; }
            if (cbk < 32) {
                ss += __shfl_xor(ss, 1); ss += __shfl_xor(ss, 2); ss += __shfl_xor(ss, 4); ss += __shfl_xor(ss, 8);
                const float sc = __builtin_amdgcn_rsqf(ss + 1e-6f);
#pragma unroll
                for (int q = 0; q < 8; ++q) r[q] *= sc; }
            u32x4 w; w.x = pk2(r[0], r[1]); w.y = pk2(r[2], r[3]); w.z = pk2(r[4], r[5]); w.w = pk2(r[6], r[7]);
            *(u32x4*)(P + (size_t)tok * 6144 + seg * 8) = w; }
        u += G;
        if (u >= 12288) break;
    }
#undef QKV_ITEM_PTR
#undef QKV_LOAD
    __syncthreads();
}
DI bf16x8 pack_acc(const f32x16& x, int s) {
    u32x4 q; q.x = pk2(x[8 * s], x[8 * s + 1]); q.y = pk2(x[8 * s + 2], x[8 * s + 3]); q.z = pk2(x[8 * s + 4], x[8 * s + 5]); q.w = pk2(x[8 * s + 6], x[8 * s + 7]);
    return __builtin_bit_cast(bf16x8, q);
}
DI bf16x8 read_perm(const LAS bf16_t* base, int pitch, int row, int col0, int hh) {
    const LAS bf16_t* q = base + row * pitch + col0 + 4 * hh;
    union { u32x2 h[2]; bf16x8 v; } u; u.h[0] = *(const LAS u32x2*)q; u.h[1] = *(const LAS u32x2*)(q + 8); return u.v;
}
DI bf16x8 read_perm_sw(const LAS bf16_t* base, int row, int col0, int hh) {
    const int sw = (row >> 3) & 15, g0 = (col0 >> 2) + hh;
    const LAS bf16_t* q = base + row * 72;
    union { u32x2 h[2]; bf16x8 v; } u; u.h[0] = *(const LAS u32x2*)(q + ((g0 ^ sw) << 2)); u.h[1] = *(const LAS u32x2*)(q + (((g0 + 2) ^ sw) << 2)); return u.v;
}
DI int scan_row(int n, int tau, int b, int dir) {
    if (n < 4) { const int pz = n * 64 + tau; return NTOK + b * CTXL + (dir ? (CTXL - 1 - pz) : pz); }
    const int pz = (n - 4) * 64 + tau; return b * SEQL + (dir ? (SEQL - 1 - pz) : pz);
}
__host__ __device__ constexpr int tri_off(int t) { return t == 0 ? 0 : 4 * (((t - 1) / 4 + 1) * (2 * ((t - 1) / 4) + ((t - 1) % 4))); }
constexpr int TRI_FLOATS = 2112, PREP_WAVE_BYTES = TRI_FLOATS * 4 + 512 + 32 * 36 * 4;
DI void job_prep_T(const Params& p, int item, LAS unsigned char* lds_wave) {
    LAS float* AP = (LAS float*)lds_wave;
    LAS float* GCw = AP + TRI_FLOATS;
    LAS float* BTw = GCw + 64;
    const int lane = tidx() & 63, r = lane & 31, hh = lane >> 5;
    const int n = item % 68, dir = (item / 68) & 1, h = (item / 136) & 15, b = item / 2176;
    const bf16_t* P = (const bf16_t*)(p.ws + OFF_BIG);
    const float* SCv = (const float*)(p.ws + OFF_SC);
    bf16x8 kf[2][8];
#pragma unroll
    for (int rb = 0; rb < 2; ++rb) { const bf16_t* src = P + (size_t)scan_row(n, 32 * rb + r, b, dir) * 6144 + 2048 + h * 128 + 8 * hh;
#pragma unroll
        for (int ks = 0; ks < 8; ++ks) kf[rb][ks] = *(const bf16x8*)(src + 16 * ks); }
    {
        const int row = scan_row(n, lane, b, dir);
        float g = SCv[(size_t)row * 64 + 32 + dir * 16 + h];
        const float bt = SCv[(size_t)row * 64 + dir * 16 + h];
#pragma unroll
        for (int o = 1; o < 64; o <<= 1) { const float v = __shfl_up(g, o); if (lane >= o) g += v; }
        GCw[lane] = g; BTw[lane] = bt;
        ((float*)(p.ws + OFF_GCG))[(size_t)item * 64 + lane] = g;
    }
    f32x16 a00, a10, a11;
#pragma unroll
    for (int i = 0; i < 16; ++i) { a00[i] = 0.f; a10[i] = 0.f; a11[i] = 0.f; }
#pragma unroll
    for (int ks = 0; ks < 8; ++ks) { a00 = MFMA32(kf[0][ks], kf[0][ks], a00); a10 = MFMA32(kf[1][ks], kf[0][ks], a10); a11 = MFMA32(kf[1][ks], kf[1][ks], a11); }
    {
        const float gs0 = GCw[r], gs1 = GCw[32 + r];
#pragma unroll
        for (int i = 0; i < 16; ++i) { const int t0 = crow(i, hh), t1 = 32 + t0; const float g0 = GCw[t0], g1 = GCw[t1], b0 = BTw[t0], b1 = BTw[t1];
            if (r < t0) AP[tri_off(t0) + r] = a00[i] * b0 * __expf(g0 - gs0);
            AP[tri_off(t1) + r] = a10[i] * b1 * __expf(g1 - gs0);
            if (r < t0) AP[tri_off(t1) + 32 + r] = a11[i] * b1 * __expf(g1 - gs1); }
    }
    bf16_t* TG = (bf16_t*)(p.ws + OFF_TMG) + (size_t)item * 3072;
    LAS float* TL = BTw + 64;
    float Tc[32];
#pragma unroll
    for (int t = 0; t < 32; ++t) {
        float a[4] = {(r == t) ? 1.f : 0.f, 0.f, 0.f, 0.f};
        const LAS float* arow = AP + (hh ? (tri_off(32 + t) + 32) : tri_off(t));
#pragma unroll
        for (int s4 = 0; s4 < (t + 3) / 4; ++s4) { const f32x4 av = *(const LAS f32x4*)(arow + 4 * s4);
#pragma unroll
            for (int e = 0; e < 4; ++e) if (4 * s4 + e < t) a[e] -= av[e] * Tc[4 * s4 + e]; }
        Tc[t] = (a[0] + a[1]) + (a[2] + a[3]);
        TG[2048 * hh + t * 32 + r] = f2bf(Tc[t]);
        if (hh) TL[t * 36 + r] = Tc[t];
    }
    f32x16 W;
#pragma unroll
    for (int i = 0; i < 16; ++i) W[i] = 0.f;
    {
        const LAS float* a10 = AP + tri_off(32 + r) + 8 * hh;
#pragma unroll
        for (int ks = 0; ks < 2; ++ks) {
            const f32x4 x0 = *(const LAS f32x4*)(a10 + 16 * ks), x1 = *(const LAS f32x4*)(a10 + 16 * ks + 4);
            u32x4 qa; qa.x = pk2(x0[0], x0[1]); qa.y = pk2(x0[2], x0[3]); qa.z = pk2(x1[0], x1[1]); qa.w = pk2(x1[2], x1[3]);
            float bsel[8];
#pragma unroll
            for (int j = 0; j < 8; ++j) { const float up = __shfl_xor(Tc[16 * ks + 8 + j], 32); bsel[j] = hh ? up : Tc[16 * ks + j]; }
            u32x4 qb; qb.x = pk2(bsel[0], bsel[1]); qb.y = pk2(bsel[2], bsel[3]); qb.z = pk2(bsel[4], bsel[5]); qb.w = pk2(bsel[6], bsel[7]);
            W = MFMA32(__builtin_bit_cast(bf16x8, qa), __builtin_bit_cast(bf16x8, qb), W);
        }
    }
    f32x16 T10;
#pragma unroll
    for (int i = 0; i < 16; ++i) T10[i] = 0.f;
#pragma unroll
    for (int sx = 0; sx < 2; ++sx) {
        const LAS float* tr = TL + r * 36 + 16 * sx + 4 * hh;
        const f32x4 x0 = *(const LAS f32x4*)tr, x1 = *(const LAS f32x4*)(tr + 8);
        u32x4 qa; qa.x = pk2(x0[0], x0[1]); qa.y = pk2(x0[2], x0[3]); qa.z = pk2(x1[0], x1[1]); qa.w = pk2(x1[2], x1[3]);
        T10 = MFMA32(__builtin_bit_cast(bf16x8, qa), pack_acc(W, sx), T10);
    }
#pragma unroll
    for (int i = 0; i < 16; ++i) TG[1024 + crow(i, hh) * 32 + r] = f2bf(-T10[i]);
}
constexpr int SC_QN = 0, SC_KN = 17408, SC_VN = 34816, SC_KT = 52224, SC_TM = 70656, SC_QK = 78336, SC_OST = 87552, SC_GC = 104960, SC_BT = 105216, SC_EG = 105472, SC_EK = 105728;
struct FB4 { u32x2 h[4][2]; };
DI void fb_rd(FB4& f, int i, unsigned a0, unsigned a1) { asm volatile("ds_read_b64 %0, %1" : "=v"(f.h[i][0]) : "v"(a0)); asm volatile("ds_read_b64 %0, %1" : "=v"(f.h[i][1]) : "v"(a1)); }
DI void fb_wait(FB4& f) {
    asm volatile("s_waitcnt lgkmcnt(0)" : "+v"(f.h[0][0]), "+v"(f.h[0][1]), "+v"(f.h[1][0]), "+v"(f.h[1][1]), "+v"(f.h[2][0]), "+v"(f.h[2][1]), "+v"(f.h[3][0]), "+v"(f.h[3][1]) :: "memory");
}
DI bf16x8 fb_get(const FB4& f, int i) { union { u32x2 h[2]; bf16x8 v; } u; u.h[0] = f.h[i][0]; u.h[1] = f.h[i][1]; return u.v; }
DI void fb_issue_nat(FB4& f, unsigned base, int kb) {
#pragma unroll
    for (int s = 0; s < 2; ++s)
#pragma unroll
        for (int tb = 0; tb < 2; ++tb) { const unsigned a = base + (unsigned)(tb * 32 * 272 + (32 * kb + 16 * s) * 2); fb_rd(f, 2 * s + tb, a, a + 16u); }
}
DI void fb_rd_tr(FB4& f, int i, unsigned a0, unsigned a1) { asm volatile("ds_read_b64_tr_b16 %0, %1" : "=v"(f.h[i][0]) : "v"(a0)); asm volatile("ds_read_b64_tr_b16 %0, %1" : "=v"(f.h[i][1]) : "v"(a1)); }
DI void fb_issue_kt(FB4& f, int kp, int s, int lane) {
    const int li = lane & 15, q = li >> 2, pp = li & 3, gcol = (lane >> 4) & 1, hh = lane >> 5;
#pragma unroll
    for (int kk = 0; kk < 2; ++kk)
#pragma unroll
        for (int half = 0; half < 2; ++half) { const int tau0 = 32 * half + 16 * s + 4 * hh + q, dk = 32 * (2 * kp + kk) + 16 * gcol + 4 * pp;
            const unsigned a = (unsigned)(SC_KN + (tau0 * 136 + dk) * 2); fb_rd_tr(f, 2 * kk + half, a, a + 8u * 272u); }
}
DI void fb_issue_tri(FB4& f, unsigned a00, unsigned a10, unsigned a11, int s) {
    fb_rd(f, 0, a00 + 32u * s, a00 + 32u * s + 16u); fb_rd(f, 1, a10 + 32u * s, a10 + 32u * s + 16u); fb_rd(f, 2, a11 + 32u * s, a11 + 32u * s + 16u); fb_rd(f, 3, a00 + 32u * s, a00 + 32u * s + 16u);
}
DI void job_scan(const Params& p, int item, LAS unsigned char* lds) {
    LAS bf16_t* QN = (LAS bf16_t*)(lds + SC_QN);
    LAS bf16_t* KN = (LAS bf16_t*)(lds + SC_KN);
    LAS bf16_t* VN = (LAS bf16_t*)(lds + SC_VN);
    LAS bf16_t* TM = (LAS bf16_t*)(lds + SC_TM);
    LAS bf16_t* QK = (LAS bf16_t*)(lds + SC_QK);
    LAS bf16_t* OST = (LAS bf16_t*)(lds + SC_OST);
    LAS float* GC = (LAS float*)(lds + SC_GC);
    LAS float* BT = (LAS float*)(lds + SC_BT);
    LAS float* EG = (LAS float*)(lds + SC_EG);
    LAS float* EK = (LAS float*)(lds + SC_EK);
    const int tid0 = tidx(), w = __builtin_amdgcn_readfirstlane(tid0 >> 6);
    const int b = item >> 5, h = (item >> 1) & 15, dir = item & 1;
    const bf16_t* P = (const bf16_t*)(p.ws + OFF_BIG);
    const float* SCv = (const float*)(p.ws + OFF_SC);
    const bf16_t* TG = (const bf16_t*)(p.ws + OFF_TMG) + (size_t)item * 68 * 3072;
    const float* GCGv = (const float*)(p.ws + OFF_GCG) + (size_t)item * 68 * 64;
    bf16_t* O = (bf16_t*)p.out + (dir ? (size_t)NTOK * D : 0);
    const float qscale = 0.08838834764831845f;
    f32x16 S[4];
#pragma unroll
    for (int kb = 0; kb < 4; ++kb)
#pragma unroll
        for (int i = 0; i < 16; ++i) S[kb][i] = 0.f;
    int tid = tid0, lane = tid0 & 63, r = lane & 31, hh = lane >> 5;
    u32x4 pq[2], pk[2], pv[2], pt = (u32x4){0u, 0u, 0u, 0u}; float pg = 0.f, pb = 0.f;
#define SCAN_PREFETCH(nn) do { _Pragma("unroll") for (int ps = 0; ps < 2; ++ps) { const int tau_ = (tid >> 4) + 32 * ps, seg_ = tid & 15; \
            const bf16_t* src_ = P + (size_t)scan_row((nn), tau_, b, dir) * 6144 + h * 128 + seg_ * 8; \
            pq[ps] = *(const u32x4*)src_; pk[ps] = *(const u32x4*)(src_ + 2048); pv[ps] = *(const u32x4*)(src_ + 4096); } \
        if (tid < 384) pt = *(const u32x4*)(TG + (size_t)(nn) * 3072 + tid * 8); \
        if (w == 0) { const int row_ = scan_row((nn), lane, b, dir); pg = GCGv[(size_t)(nn) * 64 + lane]; pb = SCv[(size_t)row_ * 64 + dir * 16 + h]; } } while (0)
    SCAN_PREFETCH(0);
#pragma unroll 1
    for (int n = 0; n < 68; ++n) {
        tid = tid0; asm volatile("" : "+v"(tid));
        lane = tid & 63; r = lane & 31; hh = lane >> 5;
        LDS_BARRIER();
        if (w == 0) {
            const float g = pg;
            const float gl = __builtin_bit_cast(float, __builtin_amdgcn_readlane(__builtin_bit_cast(int, g), 63));
            GC[lane] = g; BT[lane] = pb; EG[lane] = __expf(g); EK[lane] = __expf(gl - g);
        }
#pragma unroll
        for (int ps = 0; ps < 2; ++ps) { const int tau = (tid >> 4) + 32 * ps, seg = tid & 15;
            if (n >= 5) *(u32x4*)(O + (size_t)scan_row(n - 1, tau, b, dir) * 2048 + h * 128 + seg * 8) = *(const LAS u32x4*)(OST + tau * 136 + seg * 8);
            *(LAS u32x4*)(QN + tau * 136 + seg * 8) = pq[ps];
            *(LAS u32x4*)(KN + tau * 136 + seg * 8) = pk[ps];
            *(LAS u32x4*)(VN + tau * 136 + seg * 8) = pv[ps];
        }
        if (tid < 384) { const int tile = tid >> 7, row = (tid & 127) >> 2, seg = tid & 3; *(LAS u32x4*)(TM + tile * 1280 + row * 40 + seg * 8) = pt; }
        if (n + 1 < 68) SCAN_PREFETCH(n + 1);
        LDS_BARRIER();
        f32x16 V0, V1;
        const int dv0 = 32 * (w & 3);
        if (w >= 4) {
            if (w < 7) {
                const int tb = (w == 4) ? 0 : 1, sb = (w == 6) ? 1 : 0;
                f32x16 acc;
#pragma unroll
                for (int i = 0; i < 16; ++i) acc[i] = 0.f;
                const LAS bf16_t* Ab = QN + (32 * tb + r) * 136 + 8 * hh;
                const LAS bf16_t* Bb = KN + (32 * sb + r) * 136 + 8 * hh;
                bf16x8 af[8], bfr[8];
#pragma unroll
                for (int ks = 0; ks < 8; ++ks) { af[ks] = *(const LAS bf16x8*)(Ab + 16 * ks); bfr[ks] = *(const LAS bf16x8*)(Bb + 16 * ks); }
                const int s = 32 * sb + r; const float gs = GC[s];
                f32x4 gt4[4];
#pragma unroll
                for (int g4 = 0; g4 < 4; ++g4) gt4[g4] = *(const LAS f32x4*)(GC + 32 * tb + 8 * g4 + 4 * hh);
#pragma unroll
                for (int ks = 0; ks < 8; ++ks) acc = MFMA32(af[ks], bfr[ks], acc);
#pragma unroll
                for (int i = 0; i < 16; ++i) { const int t = 32 * tb + crow(i, hh); const float dg = fminf(gt4[i >> 2][i & 3] - gs, 0.f);
                    const float v = (s <= t) ? acc[i] * qscale * __expf(dg) : 0.f; QK[t * 72 + s] = f2bf(v); }
            }
        } else {
            f32x16 P0, P1;
#pragma unroll
            for (int i = 0; i < 16; ++i) { P0[i] = 0.f; P1[i] = 0.f; V0[i] = 0.f; V1[i] = 0.f; }
            FB4 fa, fb;
            const unsigned knb = (unsigned)(SC_KN + (r * 136 + 4 * hh) * 2);
            const unsigned tm0 = (unsigned)(SC_TM + (r * 40 + 4 * hh) * 2);
            fb_issue_nat(fa, knb, 0);
#define SCAN_P4(F, kb) do { _Pragma("unroll") for (int s_ = 0; s_ < 2; ++s_) { const bf16x8 sf_ = pack_acc(S[kb], s_); \
                P0 = MFMA32(fb_get(F, 2 * s_), sf_, P0); P1 = MFMA32(fb_get(F, 2 * s_ + 1), sf_, P1); } } while (0)
            fb_wait(fa); fb_issue_nat(fb, knb, 1); SCAN_P4(fa, 0);
            fb_wait(fb); fb_issue_nat(fa, knb, 2); SCAN_P4(fb, 1);
            fb_wait(fa); fb_issue_nat(fb, knb, 3); SCAN_P4(fa, 2);
            fb_wait(fb); fb_issue_tri(fa, tm0, tm0 + 2560u, tm0 + 5120u, 0); SCAN_P4(fb, 3);
#undef SCAN_P4
#pragma unroll
            for (int i = 0; i < 16; ++i) { const int t0 = crow(i, hh), t1 = 32 + t0;
                P0[i] = BT[t0] * (bf2f(VN[t0 * 136 + dv0 + r]) - EG[t0] * P0[i]); P1[i] = BT[t1] * (bf2f(VN[t1 * 136 + dv0 + r]) - EG[t1] * P1[i]); }
            fb_wait(fa); fb_issue_tri(fb, tm0, tm0 + 2560u, tm0 + 5120u, 1);
            { const bf16x8 r0 = pack_acc(P0, 0), r1 = pack_acc(P1, 0);
              V0 = MFMA32(fb_get(fa, 0), r0, V0); V1 = MFMA32(fb_get(fa, 1), r0, V1); V1 = MFMA32(fb_get(fa, 2), r1, V1); }
            fb_wait(fb);
            { const bf16x8 r0 = pack_acc(P0, 1), r1 = pack_acc(P1, 1);
              V0 = MFMA32(fb_get(fb, 0), r0, V0); V1 = MFMA32(fb_get(fb, 1), r0, V1); V1 = MFMA32(fb_get(fb, 2), r1, V1); }
        }
        LDS_BARRIER();
        if (w < 4) {
            f32x16 O0, O1;
#pragma unroll
            for (int i = 0; i < 16; ++i) { O0[i] = 0.f; O1[i] = 0.f; }
            FB4 fa, fb;
            const unsigned qnb = (unsigned)(SC_QN + (r * 136 + 4 * hh) * 2);
            const unsigned qk0 = (unsigned)(SC_QK + (r * 72 + 4 * hh) * 2);
            fb_issue_nat(fa, qnb, 0);
#define SCAN_O4(F, kb) do { _Pragma("unroll") for (int s_ = 0; s_ < 2; ++s_) { const bf16x8 sf_ = pack_acc(S[kb], s_); \
                O0 = MFMA32(fb_get(F, 2 * s_), sf_, O0); O1 = MFMA32(fb_get(F, 2 * s_ + 1), sf_, O1); } } while (0)
            fb_wait(fa); fb_issue_nat(fb, qnb, 1); SCAN_O4(fa, 0);
            fb_wait(fb); fb_issue_nat(fa, qnb, 2); SCAN_O4(fb, 1);
            fb_wait(fa); fb_issue_nat(fb, qnb, 3); SCAN_O4(fa, 2);
            fb_wait(fb); fb_issue_tri(fa, qk0, qk0 + 32u * 144u, qk0 + 32u * 144u + 64u, 0); SCAN_O4(fb, 3);
#undef SCAN_O4
#pragma unroll
            for (int i = 0; i < 16; ++i) { O0[i] *= qscale * EG[crow(i, hh)]; O1[i] *= qscale * EG[32 + crow(i, hh)]; }
            const float egl = __expf(GC[63]);
#pragma unroll
            for (int kb = 0; kb < 4; ++kb)
#pragma unroll
                for (int i = 0; i < 16; ++i) S[kb][i] *= egl;
            fb_wait(fa); fb_issue_tri(fb, qk0, qk0 + 32u * 144u, qk0 + 32u * 144u + 64u, 1);
            { const bf16x8 v0 = pack_acc(V0, 0), v1 = pack_acc(V1, 0);
              O0 = MFMA32(fb_get(fa, 0), v0, O0); O1 = MFMA32(fb_get(fa, 1), v0, O1); O1 = MFMA32(fb_get(fa, 2), v1, O1); }
            fb_wait(fb); fb_issue_kt(fa, 0, 0, lane);
            { const bf16x8 v0 = pack_acc(V0, 1), v1 = pack_acc(V1, 1);
              O0 = MFMA32(fb_get(fb, 0), v0, O0); O1 = MFMA32(fb_get(fb, 1), v0, O1); O1 = MFMA32(fb_get(fb, 2), v1, O1); }
#pragma unroll
            for (int i = 0; i < 16; ++i) { V0[i] *= EK[crow(i, hh)]; V1[i] *= EK[32 + crow(i, hh)]; }
#define SCAN_S4(F, kp, s_) do { const bf16x8 v0_ = pack_acc(V0, s_), v1_ = pack_acc(V1, s_); \
                S[2 * kp] = MFMA32(fb_get(F, 0), v0_, S[2 * kp]); S[2 * kp] = MFMA32(fb_get(F, 1), v1_, S[2 * kp]); \
                S[2 * kp + 1] = MFMA32(fb_get(F, 2), v0_, S[2 * kp + 1]); S[2 * kp + 1] = MFMA32(fb_get(F, 3), v1_, S[2 * kp + 1]); } while (0)
            fb_wait(fa); fb_issue_kt(fb, 1, 0, lane); SCAN_S4(fa, 0, 0);
            fb_wait(fb); fb_issue_kt(fa, 0, 1, lane); SCAN_S4(fb, 1, 0);
            fb_wait(fa); fb_issue_kt(fb, 1, 1, lane); SCAN_S4(fa, 0, 1);
            fb_wait(fb); SCAN_S4(fb, 1, 1);
#undef SCAN_S4
            if (n >= 4) {
#pragma unroll
                for (int i = 0; i < 16; ++i) {
                    OST[crow(i, hh) * 136 + dv0 + r] = f2bf(O0[i]);
                    OST[(32 + crow(i, hh)) * 136 + dv0 + r] = f2bf(O1[i]); }
            }
        }
    }
    __syncthreads();
#pragma unroll
    for (int ps = 0; ps < 2; ++ps) { const int tau = (tid >> 4) + 32 * ps, seg = tid & 15;
        *(u32x4*)(O + (size_t)scan_row(67, tau, b, dir) * 2048 + h * 128 + seg * 8) = *(const LAS u32x4*)(OST + tau * 136 + seg * 8); }
#undef SCAN_PREFETCH
}
DI void job_gdnin(const Params& p, int item) {
    const size_t e0 = (size_t)item * 4096 + tidx() * 8;
    const bf16_t* OF = (const bf16_t*)p.out; const bf16_t* OB = (const bf16_t*)p.out + (size_t)NTOK * D; bf16_t* ZG = (bf16_t*)(p.ws + OFF_X);
    const u32x4 a = *(const u32x4*)(OF + e0), bq = *(const u32x4*)(OB + e0), z = *(const u32x4*)(ZG + e0);
    const unsigned aw[4] = {a.x, a.y, a.z, a.w}, bw[4] = {bq.x, bq.y, bq.z, bq.w}, zw[4] = {z.x, z.y, z.z, z.w};
    float o[8]; float ss = 0.f;
#pragma unroll
    for (int q = 0; q < 4; ++q) { o[2 * q] = bflo(aw[q]) + bflo(bw[q]); o[2 * q + 1] = bfhi(aw[q]) + bfhi(bw[q]); ss += o[2 * q] * o[2 * q] + o[2 * q + 1] * o[2 * q + 1]; }
    ss += __shfl_xor(ss, 1); ss += __shfl_xor(ss, 2); ss += __shfl_xor(ss, 4); ss += __shfl_xor(ss, 8);
    const float rs = __builtin_amdgcn_rsqf(ss * (1.0f / 128.0f) + 1e-6f);
    const float* gn = p.in[22] + (e0 & 127);
    unsigned ow[4];
#pragma unroll
    for (int q = 0; q < 4; ++q) ow[q] = pk2(o[2 * q] * rs * gn[2 * q] * siluf_(bflo(zw[q])), o[2 * q + 1] * rs * gn[2 * q + 1] * siluf_(bfhi(zw[q])));
    *(u32x4*)(ZG + e0) = (u32x4){ow[0], ow[1], ow[2], ow[3]};
}
DI void job_final(const Params& p, int item) {
    const int lane = tidx() & 63, w = tidx() >> 6;
    const size_t row = (size_t)(item * 8 + w);
    const bf16_t* xr = (const bf16_t*)(p.ws + OFF_H) + row * 2048;
    float* orow = p.out + row * 2048;
    const float* nw = p.in[28];
    f32x4 xv[8]; float ss = 0.f;
#pragma unroll
    for (int i = 0; i < 8; ++i) { const u32x2 q = *(const u32x2*)(xr + (i * 64 + lane) * 4); xv[i] = (f32x4){bflo(q.x), bfhi(q.x), bflo(q.y), bfhi(q.y)};
        ss += xv[i][0] * xv[i][0] + xv[i][1] * xv[i][1] + xv[i][2] * xv[i][2] + xv[i][3] * xv[i][3]; }
    ss = wave_sum(ss);
    const float rstd = 1.0f / sqrtf(ss * (1.0f / 2048.0f) + 1e-6f);
#pragma unroll
    for (int i = 0; i < 8; ++i) { const int k = (i * 64 + lane) * 4; const f32x4 g = *(const f32x4*)(nw + k); *(f32x4*)(orow + k) = xv[i] * rstd * g; }
}


#define XB_TMO      128
#define XB_XCNT(j)  (256  + 64 * (j))
#define XB_XSUB(j)  (1280 + 64 * (j))
#define XB_XGEN(j)  (2304 + 64 * (j))
#define XB_TOP      3328
#define XB_TOPGEN   3392
#define XCD_BAR_WORDS 3456
#define XB_SPIN_CAP (1u << 18)
DI unsigned xb_ld(unsigned* p)              { return __hip_atomic_load(p, __ATOMIC_RELAXED, __HIP_MEMORY_SCOPE_AGENT); }
DI unsigned xb_add(unsigned* p, unsigned v) { return __hip_atomic_fetch_add(p, v, __ATOMIC_RELAXED, __HIP_MEMORY_SCOPE_AGENT); }
DI unsigned xb_xcc_id() { return (unsigned)__builtin_amdgcn_s_getreg((3 << 11) | 20) & 0xFu; }
#define XB_SPIN(cond, bar) do { unsigned _sp = 0; while (cond) { __builtin_amdgcn_s_sleep(0); \
    if ((++_sp & 255u) == 0u) { if (xb_ld(&(bar)[XB_TMO])) break; if (_sp > XB_SPIN_CAP) { atomicAdd(&(bar)[XB_TMO], 1u); break; } } } } while (0)
struct XcdBarrier { unsigned* bar; unsigned x; volatile LAS unsigned* st; };
DI XcdBarrier xcd_barrier_post(unsigned* bar, volatile LAS unsigned* st) {
    XcdBarrier b; b.bar = bar; b.x = xb_xcc_id(); b.st = st;
    if (threadIdx.x == 0) (void)xb_add(&bar[XB_XCNT(b.x)], 1u);
    return b;
}
DI void xcd_barrier_complete(unsigned* bar, unsigned x, unsigned& nloc, unsigned& nx) {
    const unsigned G = gridDim.x * gridDim.y * gridDim.z;
    unsigned sum, cnt, mine, sp = 0u;
    for (;;) {
        sum = 0u; cnt = 0u; mine = 0u;
#pragma unroll
        for (unsigned j = 0; j < 16; ++j) { const unsigned c = xb_ld(&bar[XB_XCNT(j)]); sum += c; cnt += (c > 0u) ? 1u : 0u; mine = (j == x) ? c : mine; }
        if (sum == G) break;
        __builtin_amdgcn_s_sleep(1);
        if ((++sp & 255u) == 0u) { if (xb_ld(&bar[XB_TMO])) break; if (sp > XB_SPIN_CAP) { atomicAdd(&bar[XB_TMO], 1u); break; } }
    }
    nloc = mine > 0u ? mine : 1u; nx = cnt > 0u ? cnt : 1u;
}
DI void xcd_barrier(const XcdBarrier& b) {
    asm volatile("s_waitcnt vmcnt(0)" ::: "memory");
    __syncthreads();
    if (threadIdx.x == 0) {
        unsigned* bar = b.bar;
        __builtin_amdgcn_s_waitcnt(0);
        unsigned nloc = b.st[0], nx = b.st[1];
        if (nloc == 0u) { xcd_barrier_complete(bar, b.x, nloc, nx); b.st[0] = nloc; b.st[1] = nx; }
        const unsigned old = xb_add(&bar[XB_XSUB(b.x)], 1u);
        const unsigned gen = old / nloc;
        if (old + 1u == (gen + 1u) * nloc) {
            __builtin_amdgcn_fence(__ATOMIC_RELEASE, "agent");
            asm volatile("s_waitcnt vmcnt(0)" ::: "memory");
            const unsigned og = xb_add(&bar[XB_TOP], 1u);
            const unsigned tg = og / nx;
            if (og + 1u == (tg + 1u) * nx) xb_add(&bar[XB_TOPGEN], 1u);
            else XB_SPIN(xb_ld(&bar[XB_TOPGEN]) == tg, bar);
            __builtin_amdgcn_fence(__ATOMIC_ACQUIRE, "agent");
            xb_add(&bar[XB_XGEN(b.x)], 1u);
            asm volatile("s_waitcnt vmcnt(0)" ::: "memory");
        } else {
            XB_SPIN(xb_ld(&bar[XB_XGEN(b.x)]) == gen, bar);
            __builtin_amdgcn_fence(__ATOMIC_ACQUIRE, "agent");
            asm volatile("s_waitcnt vmcnt(0)" ::: "memory");
        }
    }
    __syncthreads();
}

constexpr int NPHASE = 20;
DI void run_phase(const Params& p, int ph, LAS unsigned char* lds) {
    const int G = gridDim.x, bid = blockIdx.x;
    unsigned char* ws = p.ws;
    bf16_t* Hb = (bf16_t*)(ws + OFF_H);
    bf16_t* WTA = (bf16_t*)(ws + OFF_WTA); bf16_t* WTB = (bf16_t*)(ws + OFF_WTB); bf16_t* WSM = (bf16_t*)(ws + OFF_WSM);
    bf16_t* BIG = (bf16_t*)(ws + OFF_BIG);
    const float* MOD = (const float*)(ws + OFF_MOD);
    pg8::StaticOrder SO;
    switch (ph) {
    case 0: {
        const int n0 = 384, n2 = 48 * 16, tot = n0 + n2;
        for (int u = bid; u < tot; u += G) {
            if (u < n0) job_modp(p, u, lds);
            else convert_item(p.in[8], DIN, D, WTA, u - n0, 0, lds);
        }
    } break;
    case 1: {
        const int n0 = 120, n1 = 272, n2 = 0, n3 = 50 * 16, tot = n0 + n1 + n2 + n3;
        for (int u = bid; u < tot; u += G) {
            if (u < n0) { const int e = u * 512 + tidx(); const int v = e / 12288, col = e % 12288; float a = p.in[5][col];
                for (int pt = 0; pt < 16; ++pt) a += ((const float*)(ws + OFF_MODP))[((size_t)pt * 5 + v) * 12288 + col];
                ((float*)(ws + OFF_MOD))[e] = a; }
            else if (u < n0 + n1) { const int it = u - n0;
                if (it < 256) job_hrows<false>(p.in[0] + (size_t)it * 64 * 2048, p.in[6], (const float*)(ws + OFF_MODP), 16, p.in[5], it >> 6, 0, 1, Hb + (size_t)it * 64 * 2048, lds);
                else job_hrows<false>(p.in[2] + (size_t)(it - 256) * 64 * 2048, p.in[6], (const float*)(ws + OFF_MODP), 16, p.in[5], 4, 0, 1, Hb + (size_t)it * 64 * 2048, lds); }
            else convert_item(p.in[8], DIN, D, WTB, u - n0 - n1 - n2, 1, lds);
        }
    } break;
    case 3: {
        hyconv_pipe(p, lds, bid, G);
        for (int u = bid; u < 48 * 16; u += G) convert_item(p.in[8], DIN, D, WTA, u, 2, lds);
        { const int wv = tidx() >> 6; for (int u = bid * 8 + wv; u < 2048; u += G * 8) job_taps_mfma(p, u); }
    } break;
    case 4: {
        longconv_init(lds);
        longconv_pipe(p, lds, bid, G);
    } break;
    case 5: {
        hmix_pipe(p, lds, bid, G);
    } break;
    case 6: {
        pg8::Gemm g{Hb, WTB, MTOT, 6400, D}; SO.init(MTOT, 6400, G, bid);
        EpiBf16 E{BIG, 6144, 0, 24, (float*)(ws + OFF_SC), p.in[20], p.in[21]};
        pg8::gemm_phase(lds, g, SO, E);
        { const int nfull = 1700 % G, nidle = G - nfull;
          if (nfull != 0 && bid >= nfull) { __syncthreads();
              for (int u = bid - nfull; u < 768 + 512; u += nidle) {
                  if (u < 768) { const int wi = u >> 8; convert_item(p.in[23 + wi], D, D, WSM + (size_t)wi * D * D, u & 255, 3, lds); }
                  else job_filt_hidden(p, u - 768, lds); } }
          else if (nfull == 0) { __syncthreads();
              for (int u = bid; u < 768 + 512; u += G) {
                  if (u < 768) { const int wi = u >> 8; convert_item(p.in[23 + wi], D, D, WSM + (size_t)wi * D * D, u & 255, 3, lds); }
                  else job_filt_hidden(p, u - 768, lds); } } }
    } break;
    case 7: {
        qkvconv_latent_pipe(p, lds, bid, G);
        for (int u = 12288 + bid; u < 12288 + 192 + 544; u += G) { if (u < 12288 + 192) job_qkvconv(p, u, lds); else job_scal(p, u - 12288 - 192); }
    } break;
    case 19: {
        const int wv = tidx() >> 6;
        for (int u = bid * 8 + wv; u < 8704; u += G * 8) job_prep_T(p, u, lds + wv * PREP_WAVE_BYTES);
    } break;
    case 8: {
        pg8::Gemm g{Hb, WTA, NTOK, 6144, D};
        EpiBf16 E{(bf16_t*)(ws + OFF_X), 6144, 0, -1, nullptr, nullptr, nullptr};
        pg8::DynOrder DO; DO.nN = 24; DO.ntiles = 1536; DO.counters = (unsigned*)(ws + OFF_BAR) + 3456; DO.slot = (volatile LAS int*)(lds + LDS_BYTES - 32);
        if (G == 256) { if ((bid & 7) < 4) job_scan(p, (bid >> 3) * 4 + (bid & 7), lds); }
        else { for (int u = bid; u < 128; u += G) job_scan(p, u, lds); }
        __syncthreads();
        pg8::gemm_phase(lds, g, DO, E);
    } break;
    case 9: {
        pg8::Gemm g{Hb, WTA, NTOK, 6144, D}; SO.init(NTOK, 6144, G, bid);
        EpiZgGate E{(bf16_t*)(ws + OFF_X), (bf16_t*)(ws + OFF_GATE)};
        pg8::gemm_phase(lds, g, SO, E);
    } break;
    case 10: {
        for (int u = bid; u < 8192; u += G) job_gdnin(p, u);
    } break;
    case 12: {
        { pg8::Gemm g{(const bf16_t*)(ws + OFF_BIG + 2 * SZ67), WSM, NTOK, D, D}; SO.init(NTOK, D, G, bid);
          EpiGateMul E{BIG, nullptr, (const bf16_t*)(ws + OFF_GATE), 0};
          pg8::gemm_phase(lds, g, SO, E); }
        asm volatile("s_waitcnt vmcnt(0)" ::: "memory"); __syncthreads();
        { pg8::Gemm g{(const bf16_t*)(ws + OFF_X), WSM + (size_t)D * D, NTOK, D, D}; SO.init(NTOK, D, G, bid);
          EpiGateMul E{(bf16_t*)(ws + OFF_BIG + SZ67), BIG, (const bf16_t*)(ws + OFF_GATE), 2048};
          pg8::gemm_phase(lds, g, SO, E); }
    } break;
    case 14: {
        pg8::Gemm g{(const bf16_t*)(ws + OFF_BIG + SZ67), WSM + (size_t)2 * D * D, NTOK, D, D}; SO.init(NTOK, D, G, bid);
        EpiResidualBf<false> E{(bf16_t*)p.out, p.in[0], MOD, 2};
        pg8::gemm_phase(lds, g, SO, E);
    } break;
    case 15: {
        const int n0 = 256, n1 = 88 * 16, n2 = 16 * 44, tot = n0 + n1 + n2;
        for (int u = bid; u < tot; u += G) {
            if (u < n0) job_hrows<true>((const bf16_t*)p.out + (size_t)u * 64 * 2048, p.in[7], MOD, 1, nullptr, u >> 6, 3, 4, Hb + (size_t)u * 64 * 2048, lds);
            else if (u < n0 + n1) convert_item(p.in[26], 2 * DFF, D, (bf16_t*)(ws + OFF_WUP), u - n0, 4, lds);
            else convert_item(p.in[27], D, DFF, (bf16_t*)(ws + OFF_WDN), u - n0 - n1, 3, lds);
        }
    } break;
    case 16: {
        pg8::Gemm g{Hb, (const bf16_t*)(ws + OFF_WUP), NTOK, 2 * DFF, D}; SO.init(NTOK, 2 * DFF, G, bid);
        EpiSwiglu E{BIG};
        pg8::gemm_phase(lds, g, SO, E);
    } break;
    case 17: {
        pg8::Gemm g{BIG, (const bf16_t*)(ws + OFF_WDN), NTOK, D, DFF}; SO.init(NTOK, D, G, bid);
        EpiResidualBf<true> E{Hb, (const bf16_t*)p.out, MOD, 5};
        pg8::gemm_phase(lds, g, SO, E);
    } break;
    case 18: {
        for (int u = bid; u < 2048; u += G) job_final(p, u);
    } break;
    default: break;
    }
}

#if MULTI_LAUNCH
template <int PH>
__global__ void __launch_bounds__(NTHREADS) phase_kernel(Params p) {
    extern __shared__ __attribute__((aligned(16))) unsigned char lds_raw[];
    run_phase(p, PH, (LAS unsigned char*)lds_raw);
}
template <int PH> static void launch_phases(const Params& p, int grid, hipStream_t stream) {
    hipFuncSetAttribute((const void*)phase_kernel<PH>, hipFuncAttributeMaxDynamicSharedMemorySize, LDS_BYTES);
    hipLaunchKernelGGL(phase_kernel<PH>, dim3(grid), dim3(NTHREADS), LDS_BYTES, stream, p);
    if constexpr (PH + 1 < NPHASE) launch_phases<PH + 1>(p, grid, stream);
}
#else
__global__ void __launch_bounds__(NTHREADS) fwd_megakernel(Params p) {
    extern __shared__ __attribute__((aligned(16))) unsigned char lds_raw[];
    LAS unsigned char* lds = (LAS unsigned char*)lds_raw;
    cg::grid_group grid = cg::this_grid();
    volatile LAS unsigned* bst = (volatile LAS unsigned*)(lds + LDS_BYTES - 16);
    if (threadIdx.x < 4) bst[threadIdx.x] = 0u;
    __syncthreads();
    (void)xcd_barrier_post((unsigned*)(p.ws + OFF_BAR), bst);
#define XB_NOW() xcd_barrier(XcdBarrier{(unsigned*)(p.ws + OFF_BAR), xb_xcc_id(), (volatile LAS unsigned*)(lds + LDS_BYTES - 16)})
#ifndef PROBE_MASK
#define PROBE_MASK 0
#endif
#ifndef PROBE_SYNCS
#define PROBE_SYNCS 0
#endif
#define PH(k) run_phase(p, k, lds); XB_NOW(); if ((PROBE_MASK >> k) & 1) { run_phase(p, k, lds); XB_NOW(); }
    run_phase(p, 0, lds); grid.sync();
    PH(1) PH(6) PH(7) PH(19) PH(8) PH(3) PH(4) PH(5) PH(9) PH(10) PH(12) PH(14) PH(15) PH(16) PH(17)
    for (int i = 0; i < PROBE_SYNCS; ++i) XB_NOW();
    run_phase(p, 18, lds);
#undef PH
}
#endif

extern "C" void kernel_launch(void* const* d_in, const int* in_sizes, int n_in, void* d_out, int out_size, void* d_ws, size_t ws_size, hipStream_t stream) {
    static int grid = 0;
    if (grid == 0) {
        if (n_in != 29 || ws_size < WS_END) { fprintf(stderr, "kernel_launch: need 29 inputs and %zu B workspace; got %d, %zu\n", (size_t)WS_END, n_in, ws_size); grid = -1; return; }
        int dev = 0, cus = 0;
        hipGetDevice(&dev);
        hipDeviceGetAttribute(&cus, hipDeviceAttributeMultiprocessorCount, dev);
#if !MULTI_LAUNCH
        int per_cu = 0;
        hipFuncSetAttribute((const void*)fwd_megakernel, hipFuncAttributeMaxDynamicSharedMemorySize, LDS_BYTES);
        hipOccupancyMaxActiveBlocksPerMultiprocessor(&per_cu, (const void*)fwd_megakernel, NTHREADS, LDS_BYTES);
        if (per_cu < 1) { fprintf(stderr, "kernel_launch: occupancy query says %d blocks per CU\n", per_cu); }
#endif
        grid = cus > 0 ? cus : 256;
    }
    if (grid < 0) return;
    Params p{};
    for (int i = 0; i < 29; ++i) p.in[i] = (const float*)d_in[i];
    p.out = (float*)d_out; p.ws = (unsigned char*)d_ws;
#if MULTI_LAUNCH
    launch_phases<0>(p, grid, stream);
#else
    if (hipMemsetAsync((char*)d_ws + OFF_BAR, 0, 16384, stream) != hipSuccess) { fprintf(stderr, "kernel_launch: memset of barrier words failed\n"); return; }
    void* args[] = {&p};
    hipError_t e = hipLaunchCooperativeKernel((const void*)fwd_megakernel, dim3(grid), dim3(NTHREADS), args, LDS_BYTES, stream);
    if (e != hipSuccess) fprintf(stderr, "cooperative launch failed: %s (grid %d)\n", hipGetErrorString(e), grid);
#endif
}
```

```cpp
#include <hip/hip_runtime.h>
#include <hip/hip_cooperative_groups.h>
#include <cstdio>
namespace cg = cooperative_groups;

#define DI __device__ __forceinline__
#define LAS __attribute__((address_space(3)))
typedef unsigned short bf16_t;
typedef short bf16x8 __attribute__((ext_vector_type(8)));
typedef float f32x4 __attribute__((ext_vector_type(4)));
typedef float f32x2 __attribute__((ext_vector_type(2)));
typedef float f32x16 __attribute__((ext_vector_type(16)));
typedef unsigned u32x4 __attribute__((ext_vector_type(4)));
typedef unsigned u32x2 __attribute__((ext_vector_type(2)));
typedef __bf16 bf16v2 __attribute__((ext_vector_type(2)));

#ifndef MULTI_LAUNCH
#define MULTI_LAUNCH 0
#endif

constexpr int D = 2048, NB = 4, SEQL = 4096, NTOK = 16384, CTXL = 256, NCTX = 1024, MTOT = 17408;
constexpr int NH = 16, DFF = 5632, DIN = 18496;
constexpr int COL_QKV = 6144, COL_Z = 12288, COL_SCAL = 14336, COL_GATE = 14400;
constexpr int NTHREADS = 512;
constexpr int LDS_BYTES = 135168;

constexpr size_t al256(size_t x) { return (x + 255) & ~(size_t)255; }
constexpr size_t OFF_BAR = 0;
constexpr size_t OFF_MODP = 16384;
constexpr size_t OFF_MOD  = al256(OFF_MODP + (size_t)16 * 5 * 12288 * 4);
constexpr size_t OFF_H3   = al256(OFF_MOD + (size_t)5 * 12288 * 4);
constexpr size_t OFF_GCG  = al256(OFF_H3 + (size_t)4096 * 64 * 4);
constexpr size_t OFF_SC   = al256(OFF_GCG + (size_t)8704 * 64 * 4);
constexpr size_t OFF_H    = al256(OFF_SC + (size_t)MTOT * 64 * 4);
constexpr size_t OFF_WTA  = al256(OFF_H + (size_t)MTOT * D * 2);
constexpr size_t OFF_WSM  = al256(OFF_WTA + (size_t)6400 * D * 2);
constexpr size_t OFF_BIG  = al256(OFF_WSM + (size_t)3 * D * D * 2);
constexpr size_t OFF_X    = al256(OFF_BIG + (size_t)MTOT * 6144 * 2);
constexpr size_t OFF_Y    = OFF_X + (size_t)NTOK * D * 2;
constexpr size_t OFF_HMIX = OFF_Y + (size_t)NTOK * D * 2;
constexpr size_t OFF_WTB  = OFF_HMIX + (size_t)NTOK * D * 2;
constexpr size_t OFF_TMG  = OFF_WTB;
constexpr size_t WS_END   = OFF_TMG + (size_t)8704 * 3072 * 2;
constexpr size_t OFF_TAPS = OFF_TMG;
constexpr size_t SZ67     = (size_t)NTOK * D * 2;
constexpr size_t OFF_GATE = OFF_Y;
constexpr size_t OFF_WUP  = OFF_X;
constexpr size_t OFF_WDN  = OFF_X + (size_t)11264 * D * 2;

struct Params { const float* in[29]; float* out; unsigned char* ws; };

DI unsigned pk2(float lo, float hi) { f32x2 v = {lo, hi}; return __builtin_bit_cast(unsigned, __builtin_convertvector(v, bf16v2)); }
DI float bflo(unsigned w) { return __uint_as_float(w << 16); }
DI float bfhi(unsigned w) { return __uint_as_float(w & 0xffff0000u); }
DI float bf2f(bf16_t v) { return __uint_as_float(((unsigned)v) << 16); }
DI bf16_t f2bf(float f) { return (bf16_t)(pk2(f, 0.f) & 0xffffu); }
DI float sigmoidf_(float x) { return __builtin_amdgcn_rcpf(1.0f + __expf(-x)); }
DI float siluf_(float x) { return x * __builtin_amdgcn_rcpf(1.0f + __expf(-x)); }
DI float wave_sum(float v) {
#pragma unroll
    for (int o = 32; o >= 1; o >>= 1) v += __shfl_xor(v, o);
    return v;
}
DI int tidx() { int t = threadIdx.x; asm volatile("" : "+v"(t)); return t; }
DI int crow(int reg, int h) { return (reg & 3) + 8 * (reg >> 2) + 4 * h; }
#define LDS_BARRIER() do { asm volatile("s_waitcnt lgkmcnt(0)" ::: "memory"); __builtin_amdgcn_s_barrier(); asm volatile("" ::: "memory"); } while (0)
#define MFMA32(a, b, c) __builtin_amdgcn_mfma_f32_32x32x16_bf16((a), (b), (c), 0, 0, 0)

namespace pg8 {
constexpr int BM = 256, BK = 64, HALF = 128, HTB = HALF * BK * 2, STAGE_BYTES = 8 * HTB, NXCD = 8, WGM = 8;
DI int lds_byte(int r, int c) { const int st = (r >> 4) * 2 + (c >> 5), rr = r & 15, cc = c & 31, ob = rr * 64 + cc * 2; return st * 1024 + (ob ^ (((ob >> 9) & 1) << 5)); }
DI void stage_rc(int b, int& R, int& C) { const int st = b / 1024, sb = b % 1024, swz = sb ^ (((sb >> 9) & 1) << 5); R = (st >> 1) * 16 + swz / 64; C = (st & 1) * 32 + (swz % 64) / 2; }
DI int perm32(int rho) { const int n = rho >> 4, i = rho & 15; return 8 * (i >> 2) + 4 * n + (i & 3); }
struct Unit { int pm, pn; };
struct Gemm { const bf16_t* A; const bf16_t* Bt; int M, N, K; };
struct StaticOrder {
    int nM, nN, nwg, G, c;
    DI void init(int M, int N, int G_, int c_) { nM = M / BM; nN = N / BM; nwg = nM * nN; G = G_; c = c_; }
    DI bool next(int i, Unit& u) const {
        const long Lx = (long)i * G + c; if (Lx >= nwg) return false;
        int wgid = (int)Lx; { const int q = nwg / NXCD, r = nwg % NXCD, xcd = wgid % NXCD, off = wgid / NXCD; wgid = (xcd < r ? xcd * (q + 1) : r * (q + 1) + (xcd - r) * q) + off; }
        const int nig = WGM * nN, gid = wgid / nig, fm = gid * WGM, gsz = (nM - fm) < WGM ? (nM - fm) : WGM;
        u.pm = fm + ((wgid % nig) % gsz); u.pn = (wgid % nig) / gsz; return true;
    }
};
struct DynOrder {
    int nN, ntiles; unsigned* counters; volatile LAS int* slot;
    DI bool next(int, Unit& u) const {
        if (threadIdx.x == 0) {
            const int chunk = ntiles >> 3; const int x0 = (int)(__builtin_amdgcn_s_getreg((3 << 11) | 20) & 7u); int t0 = -1;
            for (int a = 0; a < 8; ++a) { const int j = (x0 + a) & 7;
                const int c = (int)__hip_atomic_fetch_add(counters + 16 * j, 1u, __ATOMIC_RELAXED, __HIP_MEMORY_SCOPE_AGENT);
                if (c < chunk) { t0 = j * chunk + c; break; } }
            *slot = t0; }
        asm volatile("s_waitcnt lgkmcnt(0)" ::: "memory"); __builtin_amdgcn_s_barrier(); asm volatile("" ::: "memory");
        const int t = __builtin_amdgcn_readfirstlane(*slot);
        if (t < 0) return false;
        const int nig = WGM * nN, gid = t / nig, wi = t - gid * nig;
        u.pm = gid * WGM + (wi & (WGM - 1)); u.pn = wi / WGM; return true;
    }
};
struct RangeOrder {
    int nN, first, count;
    DI bool next(int i, Unit& u) const { if (i >= count) return false; const int t = first + i; u.pm = t / nN; u.pn = t - u.pm * nN; return true; }
};
template <class Epi, class Sched>
DI void gemm_phase(LAS unsigned char* lds, const Gemm g, const Sched& S, const Epi& E) {
    const int tid = tidx(), wid = __builtin_amdgcn_readfirstlane(tid >> 6), lane = tid & 63, wr = wid >> 2, wc = wid & 3, fr = lane & 15, fq = lane >> 4;
    const int K = g.K, nt = K / BK;
    unsigned voffA[2], voffB[2];
#pragma unroll
    for (int i = 0; i < 2; ++i) { int R, C; stage_rc(tid * 16 + i * 8192, R, C); const int Rb = Epi::PERM ? ((R & ~31) + perm32(R & 31)) : R;
        voffA[i] = (unsigned)(R * K + C) * 2u; voffB[i] = (unsigned)(Rb * K + C) * 2u; }
    const size_t kstep = (size_t)(BK * 2);
    const size_t hstep = (size_t)HALF * K * 2;
    const size_t tstep = 2 * hstep;
    const unsigned ldsw = (unsigned)wid * 1024u;
    const int aoff = lds_byte(wr * 64 + fr, fq * 8), boff = lds_byte(wc * 32 + fr, fq * 8);
#define PG8_SA(b, h) (((b) * 2 + (h)) * HTB)
#define PG8_SB(b, h) ((4 + (b) * 2 + (h)) * HTB)
#define PG8_STAGE(bufoff, gbase, voff) do { _Pragma("unroll") for (int _i = 0; _i < 2; ++_i) \
        __builtin_amdgcn_global_load_lds((const unsigned*)((const char*)(gbase) + (voff)[_i]), (LAS unsigned*)(lds + (bufoff) + ldsw + _i * 8192), 16, 0, 0); } while (0)
#define PG8_LDA(dst, b, h) do { _Pragma("unroll") for (int m = 0; m < 4; ++m) _Pragma("unroll") for (int k = 0; k < 2; ++k) dst[m][k] = *(const LAS bf16x8*)(lds + PG8_SA(b, h) + aoff + m * 2048 + k * 1024); } while (0)
#define PG8_LDB(dst, b, h) do { _Pragma("unroll") for (int n = 0; n < 2; ++n) _Pragma("unroll") for (int k = 0; k < 2; ++k) dst[n][k] = *(const LAS bf16x8*)(lds + PG8_SB(b, h) + boff + n * 2048 + k * 1024); } while (0)
#define PG8_MMA(ai, bj, At, Bt) do { __builtin_amdgcn_s_setprio(1); _Pragma("unroll") for (int m = 0; m < 4; ++m) _Pragma("unroll") for (int n = 0; n < 2; ++n) _Pragma("unroll") for (int k = 0; k < 2; ++k) \
        acc[ai][bj][m][n] = __builtin_amdgcn_mfma_f32_16x16x32_bf16(Bt[n][k], At[m][k], acc[ai][bj][m][n], 0, 0, 0); __builtin_amdgcn_s_setprio(0); } while (0)
#define PG8_WAIT_V(n) asm volatile("s_waitcnt vmcnt(" #n ")" ::: "memory")
#define PG8_WAIT_L(n) asm volatile("s_waitcnt lgkmcnt(" #n ")" ::: "memory")
#define PG8_BAR __builtin_amdgcn_s_barrier()
#define PG8_SCHED __builtin_amdgcn_sched_barrier(0)
    Unit cur, nxt; int ui = 0;
    if (!S.next(0, cur)) return;
    f32x4 acc[2][2][4][2];
#pragma unroll
    for (int a = 0; a < 2; ++a)
#pragma unroll
        for (int b = 0; b < 2; ++b)
#pragma unroll
            for (int m = 0; m < 4; ++m)
#pragma unroll
                for (int n = 0; n < 2; ++n) acc[a][b][m][n] = (f32x4){0.f, 0.f, 0.f, 0.f};
    bf16x8 At[4][2], B0[2][2], B1[2][2];
    const char* cA = (const char*)g.A + (size_t)cur.pm * tstep; const char* cB = (const char*)g.Bt + (size_t)cur.pn * tstep;
    PG8_STAGE(PG8_SB(0, 0), cB, voffB); PG8_STAGE(PG8_SA(0, 0), cA, voffA); PG8_STAGE(PG8_SB(0, 1), cB + hstep, voffB); PG8_STAGE(PG8_SA(0, 1), cA + hstep, voffA);
    if (wr == 1) PG8_BAR;
    PG8_WAIT_V(4); PG8_BAR;
    PG8_STAGE(PG8_SB(1, 0), cB + kstep, voffB); PG8_STAGE(PG8_SA(1, 0), cA + kstep, voffA); PG8_STAGE(PG8_SB(1, 1), cB + hstep + kstep, voffB);
    PG8_WAIT_V(6); PG8_BAR;
    for (;;) {
        const bool has_next = S.next(ui + 1, nxt);
        const char* nA = has_next ? (const char*)g.A + (size_t)nxt.pm * tstep : cA; const char* nB = has_next ? (const char*)g.Bt + (size_t)nxt.pn * tstep : cB;
        for (int t = 0; t < nt; t += 2) {
            const bool last = (t == nt - 2);
            const char* a1 = cA + (size_t)(t + 1) * kstep;
            const char* a2 = last ? nA : cA + (size_t)(t + 2) * kstep; const char* b2 = last ? nB : cB + (size_t)(t + 2) * kstep;
            const char* a3 = a2 + kstep; const char* b3 = b2 + kstep;
            PG8_LDB(B0, 0, 0); PG8_SCHED; PG8_LDA(At, 0, 0); PG8_STAGE(PG8_SA(1, 1), a1 + hstep, voffA);
            PG8_WAIT_L(8); PG8_BAR; PG8_WAIT_L(0); PG8_MMA(0, 0, At, B0); PG8_BAR; PG8_SCHED;
            PG8_LDB(B1, 0, 1); PG8_STAGE(PG8_SB(0, 0), b2, voffB);
            PG8_BAR; PG8_WAIT_L(0); PG8_MMA(0, 1, At, B1); PG8_BAR;
            PG8_LDA(At, 0, 1); PG8_STAGE(PG8_SA(0, 0), a2, voffA);
            PG8_BAR; PG8_WAIT_L(0); PG8_MMA(1, 0, At, B0); PG8_BAR; PG8_SCHED;
            PG8_STAGE(PG8_SB(0, 1), b2 + hstep, voffB);
            PG8_WAIT_V(6); PG8_BAR; PG8_MMA(1, 1, At, B1); PG8_BAR;
            PG8_LDB(B0, 1, 0); PG8_SCHED; PG8_LDA(At, 1, 0); PG8_STAGE(PG8_SA(0, 1), a2 + hstep, voffA);
            PG8_WAIT_L(8); PG8_BAR; PG8_WAIT_L(0); PG8_MMA(0, 0, At, B0); PG8_BAR; PG8_SCHED;
            PG8_LDB(B1, 1, 1); PG8_STAGE(PG8_SB(1, 0), b3, voffB);
            PG8_BAR; PG8_WAIT_L(0); PG8_MMA(0, 1, At, B1); PG8_BAR;
            PG8_LDA(At, 1, 1); PG8_STAGE(PG8_SA(1, 0), a3, voffA);
            PG8_BAR; PG8_WAIT_L(0); PG8_MMA(1, 0, At, B0); PG8_BAR; PG8_SCHED;
            PG8_STAGE(PG8_SB(1, 1), b3 + hstep, voffB);
            PG8_WAIT_V(6); PG8_BAR; PG8_MMA(1, 1, At, B1); PG8_BAR;
        }
        E(acc, cur, wr, wc, fr, fq);
        if (!has_next) break;
#pragma unroll
        for (int a = 0; a < 2; ++a)
#pragma unroll
            for (int b = 0; b < 2; ++b)
#pragma unroll
                for (int m = 0; m < 4; ++m)
#pragma unroll
                    for (int n = 0; n < 2; ++n) acc[a][b][m][n] = (f32x4){0.f, 0.f, 0.f, 0.f};
        cur = nxt; cA = nA; cB = nB; ++ui;
    }
    PG8_WAIT_V(0);
    if (wr == 0) PG8_BAR;
    PG8_BAR;
#undef PG8_SA
#undef PG8_SB
#undef PG8_STAGE
#undef PG8_LDA
#undef PG8_LDB
#undef PG8_MMA
#undef PG8_WAIT_V
#undef PG8_WAIT_L
#undef PG8_BAR
#undef PG8_SCHED
}
}
using pg8::Unit;
typedef f32x4 AccT[2][2][4][2];

struct EpiBf16 {
    static constexpr bool PERM = true;
    bf16_t* O; int ldc; int act; int scal_pn; float* SC; const float* a_log; const float* dt_bias;
    DI void operator()(const AccT& acc, const Unit& u, int wr, int wc, int fr, int fq) const {
        const int row0 = u.pm * 256 + wr * 64 + fr;
        if (u.pn == scal_pn) {
            if (wc < 2) {
#pragma unroll
                for (int ai = 0; ai < 2; ++ai)
#pragma unroll
                    for (int m = 0; m < 4; ++m) {
                        const int row = row0 + ai * 128 + m * 16;
#pragma unroll
                        for (int n = 0; n < 2; ++n) {
                            const int c0 = 32 * wc + 8 * fq + 4 * n; const f32x4 o = acc[ai][0][m][n];
                            *(f32x4*)(SC + (size_t)row * 64 + c0) = o;
                        }
                    }
            }
            return;
        }
        const int col0 = u.pn * 256 + wc * 32 + 8 * fq;
#pragma unroll
        for (int ai = 0; ai < 2; ++ai)
#pragma unroll
            for (int m = 0; m < 4; ++m) { bf16_t* rowp = O + (size_t)(row0 + ai * 128 + m * 16) * ldc + col0;
#pragma unroll
                for (int bj = 0; bj < 2; ++bj) { f32x4 v0 = acc[ai][bj][m][0], v1 = acc[ai][bj][m][1];
                    if (act == 1) {
#pragma unroll
                        for (int j = 0; j < 4; ++j) { v0[j] = sigmoidf_(v0[j]); v1[j] = sigmoidf_(v1[j]); } }
                    u32x4 w; w.x = pk2(v0[0], v0[1]); w.y = pk2(v0[2], v0[3]); w.z = pk2(v1[0], v1[1]); w.w = pk2(v1[2], v1[3]);
                    *(u32x4*)(rowp + bj * 128) = w; } }
    }
};
struct EpiZgGate {
    static constexpr bool PERM = true;
    bf16_t* ZG; bf16_t* GATE;
    DI void operator()(const AccT& acc, const Unit& u, int wr, int wc, int fr, int fq) const {
        const int row0 = u.pm * 256 + wr * 64 + fr;
        const bool isg = u.pn >= 8;
        bf16_t* O = isg ? GATE : ZG; const int ldc = isg ? 4096 : 2048;
        const int col0 = (isg ? (u.pn - 8) : u.pn) * 256 + wc * 32 + 8 * fq;
#pragma unroll
        for (int ai = 0; ai < 2; ++ai)
#pragma unroll
            for (int m = 0; m < 4; ++m) { bf16_t* rowp = O + (size_t)(row0 + ai * 128 + m * 16) * ldc + col0;
#pragma unroll
                for (int bj = 0; bj < 2; ++bj) { f32x4 v0 = acc[ai][bj][m][0], v1 = acc[ai][bj][m][1];
                    if (isg) {
#pragma unroll
                        for (int j = 0; j < 4; ++j) { v0[j] = sigmoidf_(v0[j]); v1[j] = sigmoidf_(v1[j]); } }
                    u32x4 w; w.x = pk2(v0[0], v0[1]); w.y = pk2(v0[2], v0[3]); w.z = pk2(v1[0], v1[1]); w.w = pk2(v1[2], v1[3]);
                    *(u32x4*)(rowp + bj * 128) = w; } }
    }
};
struct EpiGateMul {
    static constexpr bool PERM = true;
    bf16_t* O; const bf16_t* add; const bf16_t* gate; int goff;
    DI void operator()(const AccT& acc, const Unit& u, int wr, int wc, int fr, int fq) const {
        const int row0 = u.pm * 256 + wr * 64 + fr, col0 = u.pn * 256 + wc * 32 + 8 * fq;
        if (!add) {
            u32x4 g2[2][4][2];
#pragma unroll
            for (int ai = 0; ai < 2; ++ai)
#pragma unroll
                for (int m = 0; m < 4; ++m)
#pragma unroll
                    for (int bj = 0; bj < 2; ++bj) g2[ai][m][bj] = *(const u32x4*)(gate + (size_t)(row0 + ai * 128 + m * 16) * 4096 + goff + col0 + bj * 128);
#pragma unroll
            for (int ai = 0; ai < 2; ++ai)
#pragma unroll
                for (int m = 0; m < 4; ++m)
#pragma unroll
                    for (int bj = 0; bj < 2; ++bj) { const u32x4 gv = g2[ai][m][bj]; const f32x4 v0 = acc[ai][bj][m][0], v1 = acc[ai][bj][m][1];
                        u32x4 w; w.x = pk2(v0[0] * bflo(gv.x), v0[1] * bfhi(gv.x)); w.y = pk2(v0[2] * bflo(gv.y), v0[3] * bfhi(gv.y));
                        w.z = pk2(v1[0] * bflo(gv.z), v1[1] * bfhi(gv.z)); w.w = pk2(v1[2] * bflo(gv.w), v1[3] * bfhi(gv.w));
                        *(u32x4*)(O + (size_t)(row0 + ai * 128 + m * 16) * 2048 + col0 + bj * 128) = w; }
            return;
        }
#pragma unroll
        for (int ai = 0; ai < 2; ++ai) {
            u32x4 gvv[4][2], avv[4][2];
#pragma unroll
            for (int m = 0; m < 4; ++m)
#pragma unroll
                for (int bj = 0; bj < 2; ++bj) { const size_t row = (size_t)(row0 + ai * 128 + m * 16); const int col = col0 + bj * 128;
                    gvv[m][bj] = *(const u32x4*)(gate + row * 4096 + goff + col);
                    avv[m][bj] = add ? *(const u32x4*)(add + row * 2048 + col) : (u32x4){0u, 0u, 0u, 0u}; }
#pragma unroll
            for (int m = 0; m < 4; ++m)
#pragma unroll
                for (int bj = 0; bj < 2; ++bj) { const size_t row = (size_t)(row0 + ai * 128 + m * 16); const int col = col0 + bj * 128;
                    const u32x4 gv = gvv[m][bj], av = avv[m][bj];
                    const f32x4 v0 = acc[ai][bj][m][0], v1 = acc[ai][bj][m][1];
                    float o[8] = { v0[0] * bflo(gv.x) + bflo(av.x), v0[1] * bfhi(gv.x) + bfhi(av.x), v0[2] * bflo(gv.y) + bflo(av.y), v0[3] * bfhi(gv.y) + bfhi(av.y),
                                   v1[0] * bflo(gv.z) + bflo(av.z), v1[1] * bfhi(gv.z) + bfhi(av.z), v1[2] * bflo(gv.w) + bflo(av.w), v1[3] * bfhi(gv.w) + bfhi(av.w) };
                    u32x4 w; w.x = pk2(o[0], o[1]); w.y = pk2(o[2], o[3]); w.z = pk2(o[4], o[5]); w.w = pk2(o[6], o[7]);
                    *(u32x4*)(O + row * 2048 + col) = w; }
            asm volatile("" ::: "memory"); }
    }
};
struct EpiResidual {
    static constexpr bool PERM = false;
    float* out; const float* res; const float* mod; int seg;
    DI void operator()(const AccT& acc, const Unit& u, int wr, int wc, int fr, int fq) const {
        const int row0 = u.pm * 256 + wr * 64 + fr, col0 = u.pn * 256 + wc * 32 + 4 * fq;
        const int b = (u.pm * 256) / SEQL;
        f32x4 gv[2][2];
#pragma unroll
        for (int bj = 0; bj < 2; ++bj)
#pragma unroll
            for (int n = 0; n < 2; ++n) gv[bj][n] = *(const f32x4*)(mod + (size_t)b * 12288 + seg * 2048 + col0 + bj * 128 + n * 16);
#pragma unroll
        for (int ai = 0; ai < 2; ++ai)
#pragma unroll
            for (int m = 0; m < 4; ++m) { const size_t off = (size_t)(row0 + ai * 128 + m * 16) * 2048 + col0;
#pragma unroll
                for (int bj = 0; bj < 2; ++bj)
#pragma unroll
                    for (int n = 0; n < 2; ++n) { const f32x4 bs = *(const f32x4*)(res + off + bj * 128 + n * 16);
                        *(f32x4*)(out + off + bj * 128 + n * 16) = bs + gv[bj][n] * acc[ai][bj][m][n]; }
                asm volatile("" ::: "memory"); }
    }
};
template <bool RESBF>
struct EpiResidualBf {
    static constexpr bool PERM = true;
    bf16_t* out; const void* res; const float* mod; int seg;
    DI void operator()(const AccT& acc, const Unit& u, int wr, int wc, int fr, int fq) const {
        const int row0 = u.pm * 256 + wr * 64 + fr, col0 = u.pn * 256 + wc * 32 + 8 * fq;
        const int b = (u.pm * 256) / SEQL;
        f32x4 gv[2][2];
#pragma unroll
        for (int bj = 0; bj < 2; ++bj)
#pragma unroll
            for (int n = 0; n < 2; ++n) gv[bj][n] = *(const f32x4*)(mod + (size_t)b * 12288 + seg * 2048 + col0 + bj * 128 + n * 4);
#pragma unroll
        for (int ai = 0; ai < 2; ++ai) {
            f32x4 rr[4][2][2];
#pragma unroll
            for (int m = 0; m < 4; ++m)
#pragma unroll
                for (int bj = 0; bj < 2; ++bj) { const size_t off = (size_t)(row0 + ai * 128 + m * 16) * 2048 + col0 + bj * 128;
                    if (RESBF) { const u32x4 q = *(const u32x4*)((const bf16_t*)res + off); rr[m][bj][0] = (f32x4){bflo(q.x), bfhi(q.x), bflo(q.y), bfhi(q.y)}; rr[m][bj][1] = (f32x4){bflo(q.z), bfhi(q.z), bflo(q.w), bfhi(q.w)}; }
                    else { rr[m][bj][0] = *(const f32x4*)((const float*)res + off); rr[m][bj][1] = *(const f32x4*)((const float*)res + off + 4); } }
#pragma unroll
            for (int m = 0; m < 4; ++m)
#pragma unroll
                for (int bj = 0; bj < 2; ++bj) { const size_t off = (size_t)(row0 + ai * 128 + m * 16) * 2048 + col0 + bj * 128;
                    const f32x4 o0 = rr[m][bj][0] + gv[bj][0] * acc[ai][bj][m][0], o1 = rr[m][bj][1] + gv[bj][1] * acc[ai][bj][m][1];
                    u32x4 w; w.x = pk2(o0[0], o0[1]); w.y = pk2(o0[2], o0[3]); w.z = pk2(o1[0], o1[1]); w.w = pk2(o1[2], o1[3]);
                    *(u32x4*)(out + off) = w; }
            asm volatile("" ::: "memory"); }
    }
};
struct EpiSwiglu {
    static constexpr bool PERM = true;
    bf16_t* U;
    DI void operator()(const AccT& acc, const Unit& u, int wr, int wc, int fr, int fq) const {
        const int row0 = u.pm * 256 + wr * 64 + fr, col0 = u.pn * 128 + wc * 32 + 8 * fq;
#pragma unroll
        for (int ai = 0; ai < 2; ++ai)
#pragma unroll
            for (int m = 0; m < 4; ++m) { float o[8];
#pragma unroll
                for (int n = 0; n < 2; ++n)
#pragma unroll
                    for (int j = 0; j < 4; ++j) o[n * 4 + j] = siluf_(acc[ai][0][m][n][j]) * acc[ai][1][m][n][j];
                u32x4 w; w.x = pk2(o[0], o[1]); w.y = pk2(o[2], o[3]); w.z = pk2(o[4], o[5]); w.w = pk2(o[6], o[7]);
                *(u32x4*)(U + (size_t)(row0 + ai * 128 + m * 16) * DFF + col0) = w; }
    }
};

DI void job_convert(const float* src, int ldsrc, int srccol0, int nvalid, bf16_t* dst, int K, int r0, int k0, LAS unsigned char* lds) {
    LAS bf16_t* T = (LAS bf16_t*)lds;
    const int tid = tidx();
    __syncthreads();
#pragma unroll
    for (int ps = 0; ps < 8; ++ps) {
        const int kk = (tid >> 5) + 16 * ps, n4 = (tid & 31) * 4;
        f32x4 v = (f32x4){0.f, 0.f, 0.f, 0.f};
        if (n4 < nvalid) v = *(const f32x4*)(src + (size_t)(k0 + kk) * ldsrc + srccol0 + n4);
#pragma unroll
        for (int j = 0; j < 4; ++j) T[(n4 + j) * 130 + kk] = f2bf(v[j]);
    }
    __syncthreads();
#pragma unroll
    for (int ps = 0; ps < 4; ++ps) {
        const int n = (tid >> 4) + 32 * ps, ks = (tid & 15) * 8;
        const LAS unsigned* sp = (const LAS unsigned*)(T + n * 130 + ks);
        u32x4 w; w.x = sp[0]; w.y = sp[1]; w.z = sp[2]; w.w = sp[3];
        *(u32x4*)(dst + (size_t)(r0 + n) * K + k0 + ks) = w;
    }
}
DI void convert_item(const float* src, int ldsrc, int K, bf16_t* dst, int item, int kind, LAS unsigned char* lds) {
    const int nkt = K / 128, rt = item / nkt, kt = item % nkt;
    int sc0 = 0, nv = 128;
    const int r0 = rt * 128;
    if (kind == 0) { sc0 = r0; }
    else if (kind == 1) {
        if (r0 < 6144) sc0 = COL_QKV + r0; else if (r0 == 6144) { sc0 = COL_SCAL; nv = 64; } else { sc0 = 0; nv = 0; } }
    else if (kind == 2) { sc0 = (r0 < 2048) ? COL_Z + r0 : COL_GATE + (r0 - 2048); }
    else if (kind == 3) { sc0 = r0; }
    else if (kind == 4) { const int pn = r0 / 256, w = r0 % 256; sc0 = (w < 128) ? pn * 128 : DFF + pn * 128; }
    job_convert(src, ldsrc, sc0, nv, dst, K, r0, kt * 128, lds);
}

DI void job_modp(const Params& p, int item, LAS unsigned char* lds) {
    LAS float* s = (LAS float*)lds;
    const int cb = item % 24, kc = item / 24, tid = tidx();
    __syncthreads();
    for (int i = tid; i < 640; i += NTHREADS) { const int v = i >> 7, kk = i & 127, k = kc * 128 + kk; const float c = v < 4 ? p.in[1][v * 2048 + k] : p.in[3][k]; s[i] = c / (1.0f + expf(-c)); }
    __syncthreads();
    const int col = cb * 512 + tid;
    float a0 = 0.f, a1 = 0.f, a2 = 0.f, a3 = 0.f, a4 = 0.f;
    const float* wp = p.in[4] + (size_t)(kc * 128) * 12288 + col;
#pragma unroll 32
    for (int kk = 0; kk < 128; ++kk) { const float w = wp[(size_t)kk * 12288]; a0 += s[kk] * w; a1 += s[128 + kk] * w; a2 += s[256 + kk] * w; a3 += s[384 + kk] * w; a4 += s[512 + kk] * w; }
    float* mp = (float*)(p.ws + OFF_MODP) + (size_t)kc * 5 * 12288 + col;
    mp[0] = a0; mp[12288] = a1; mp[2 * 12288] = a2; mp[3 * 12288] = a3; mp[4 * 12288] = a4;
}
DI void job_filt_hidden(const Params& p, int item, LAS unsigned char* lds) {
    LAS float* z = (LAS float*)lds;
    LAS float* ha = z + 8 * 36;
    LAS float* hb = ha + 8 * 64;
    const int tid = tidx(), pp = tid >> 6, j = tid & 63, pos = item * 8 + pp;
    __syncthreads();
    if (j < 33) {
        float v;
        if (j == 0) v = (float)pos / 4095.0f;
        else { const int bnd = (j - 1) & 15; const float f = 1e-4f + (float)bnd * ((15.0f - 1e-4f) / 15.0f); const float w = 6.283185307179586f * (float)pos / 4096.0f;
            v = (j <= 16) ? cosf(f * w) : -sinf(f * w); }
        z[pp * 36 + j] = v;
    }
    __syncthreads();
    const float fr = p.in[18][j];
    { float a = p.in[12][j];
#pragma unroll 3
        for (int i = 0; i < 33; ++i) a += z[pp * 36 + i] * p.in[11][i * 64 + j]; ha[pp * 64 + j] = sinf(fr * a); }
    __syncthreads();
    { float a = p.in[14][j];
#pragma unroll 4
        for (int i = 0; i < 64; ++i) a += ha[pp * 64 + i] * p.in[13][i * 64 + j]; hb[pp * 64 + j] = sinf(fr * a); }
    __syncthreads();
    { float a = p.in[16][j];
#pragma unroll 4
        for (int i = 0; i < 64; ++i) a += hb[pp * 64 + i] * p.in[15][i * 64 + j]; ((float*)(p.ws + OFF_H3))[(size_t)pos * 64 + j] = sinf(fr * a); }
}
DI void job_taps(const Params& p, int item, LAS unsigned char* lds) {
    LAS float* h3 = (LAS float*)lds;
    const int tid = tidx(), tb = item >> 3, jb = item & 7;
    __syncthreads();
    for (int i = tid; i < 4096; i += NTHREADS) h3[i] = ((const float*)(p.ws + OFF_H3))[(size_t)tb * 4096 + i];
    __syncthreads();
    const int col = jb * 512 + tid, dir = col >> 11, c = col & 2047;
    float fo[64];
#pragma unroll
    for (int i = 0; i < 64; ++i) fo[i] = p.in[17][(size_t)i * 4096 + col];
    const float dmin = -3.0701134573253944f, dmax = -15.350567286626973f;
    const float delta = fabsf(dmin + (float)c * ((dmax - dmin) / 2047.0f));
    bf16_t* tp = (bf16_t*)(p.ws + OFF_TAPS) + ((size_t)c * 2 + dir) * 4096 + tb * 64;
    for (int g8 = 0; g8 < 8; ++g8) {
        float v[8];
#pragma unroll
        for (int e = 0; e < 8; ++e) { const int pl = g8 * 8 + e; float a = 0.f;
#pragma unroll
            for (int i = 0; i < 64; i += 4) { const f32x4 hv = *(const LAS f32x4*)(h3 + pl * 64 + i); a += hv[0] * fo[i] + hv[1] * fo[i + 1] + hv[2] * fo[i + 2] + hv[3] * fo[i + 3]; }
            const float t = (float)(tb * 64 + pl) / 4095.0f; v[e] = a * expf(-t * delta); }
        u32x4 w; w.x = pk2(v[0], v[1]); w.y = pk2(v[2], v[3]); w.z = pk2(v[4], v[5]); w.w = pk2(v[6], v[7]);
        *(u32x4*)(tp + g8 * 8) = w;
    }
}
DI void job_taps_mfma(const Params& p, int witem) {
    const int lane = tidx() & 63, r = lane & 31, hh = lane >> 5;
    const int cbk = witem >> 4, pc = witem & 15;
    const float* fout = p.in[17]; const float* h3 = (const float*)(p.ws + OFF_H3);
    bf16x8 af[4];
#pragma unroll
    for (int ks = 0; ks < 4; ++ks) { float f[8];
#pragma unroll
        for (int j = 0; j < 8; ++j) f[j] = fout[(size_t)(16 * ks + 8 * hh + j) * 4096 + cbk * 32 + r];
        u32x4 q; q.x = pk2(f[0], f[1]); q.y = pk2(f[2], f[3]); q.z = pk2(f[4], f[5]); q.w = pk2(f[6], f[7]); af[ks] = __builtin_bit_cast(bf16x8, q); }
    const float dmin = -3.0701134573253944f, dmax = -15.350567286626973f;
    bf16_t* TP = (bf16_t*)(p.ws + OFF_TAPS);
#pragma unroll 1
    for (int pb = 0; pb < 8; ++pb) {
        const int pos = pc * 256 + pb * 32 + r;
        f32x16 acc;
#pragma unroll
        for (int i = 0; i < 16; ++i) acc[i] = 0.f;
#pragma unroll
        for (int ks = 0; ks < 4; ++ks) { const f32x4 h0 = *(const f32x4*)(h3 + (size_t)pos * 64 + 16 * ks + 8 * hh), h1 = *(const f32x4*)(h3 + (size_t)pos * 64 + 16 * ks + 8 * hh + 4);
            u32x4 q; q.x = pk2(h0[0], h0[1]); q.y = pk2(h0[2], h0[3]); q.z = pk2(h1[0], h1[1]); q.w = pk2(h1[2], h1[3]);
            acc = MFMA32(af[ks], __builtin_bit_cast(bf16x8, q), acc); }
        const float t = (float)pos / 4095.0f;
#pragma unroll
        for (int i = 0; i < 16; ++i) { const int col = cbk * 32 + crow(i, hh), dir = col >> 11, c = col & 2047;
            const float delta = fabsf(dmin + (float)c * ((dmax - dmin) / 2047.0f));
            TP[((size_t)c * 2 + dir) * 4096 + pos] = f2bf(acc[i] * __expf(-t * delta)); }
    }
}
template <bool XBF>
DI void job_hrows(const void* Xv, const float* nw, const float* modsrc, int npart, const float* bias, int v, int seg_sh, int seg_sc, bf16_t* Hout, LAS unsigned char* lds) {
    LAS float* mul = (LAS float*)lds;
    LAS float* sh = mul + 2048;
    const int tid = tidx(), lane = tid & 63, w = tid >> 6;
    __syncthreads();
    for (int k = tid; k < 2048; k += NTHREADS) {
        float sc = bias ? bias[seg_sc * 2048 + k] : 0.f, s2 = bias ? bias[seg_sh * 2048 + k] : 0.f;
        for (int pt = 0; pt < npart; ++pt) { const float* mp = modsrc + ((size_t)pt * 5 + v) * 12288; sc += mp[seg_sc * 2048 + k]; s2 += mp[seg_sh * 2048 + k]; }
        mul[k] = nw[k] * (1.0f + sc); sh[k] = s2;
    }
    __syncthreads();
    for (int rr = w; rr < 64; rr += 8) {
        f32x4 xv[8]; float ss = 0.f;
#pragma unroll
        for (int i = 0; i < 8; ++i) {
            if (XBF) { const u32x2 q = *(const u32x2*)((const bf16_t*)Xv + (size_t)rr * 2048 + (i * 64 + lane) * 4); xv[i] = (f32x4){bflo(q.x), bfhi(q.x), bflo(q.y), bfhi(q.y)}; }
            else xv[i] = *(const f32x4*)((const float*)Xv + (size_t)rr * 2048 + (i * 64 + lane) * 4);
            ss += xv[i][0] * xv[i][0] + xv[i][1] * xv[i][1] + xv[i][2] * xv[i][2] + xv[i][3] * xv[i][3]; }
        ss = wave_sum(ss);
        const float rstd = 1.0f / sqrtf(ss * (1.0f / 2048.0f) + 1e-6f);
#pragma unroll
        for (int i = 0; i < 8; ++i) { const int k = (i * 64 + lane) * 4; const f32x4 mv = *(const LAS f32x4*)(mul + k), sv = *(const LAS f32x4*)(sh + k);
            u32x2 o; o.x = pk2(xv[i][0] * rstd * mv[0] + sv[0], xv[i][1] * rstd * mv[1] + sv[1]); o.y = pk2(xv[i][2] * rstd * mv[2] + sv[2], xv[i][3] * rstd * mv[3] + sv[3]);
            *(u32x2*)(Hout + (size_t)rr * 2048 + k) = o; }
    }
}
DI void job_hyconv(const Params& p, int item, LAS unsigned char* lds) {
    LAS bf16_t* X0 = (LAS bf16_t*)lds;
    LAS bf16_t* ZT = X0 + 3 * 64 * 136;
    const int tid = tidx(), rr = item >> 4, cb = item & 15, c0 = cb * 128;
    bf16_t* P = (bf16_t*)(p.ws + OFF_X) + (size_t)rr * 64 * 6144;
    const float* cw = p.in[9];
    __syncthreads();
#pragma unroll
    for (int ps = 0; ps < 6; ++ps) { const int e = tid + ps * NTHREADS, part = e >> 10, tok = (e >> 4) & 63, seg = e & 15;
        *(LAS u32x4*)(X0 + part * 64 * 136 + tok * 136 + seg * 8) = *(const u32x4*)(P + (size_t)tok * 6144 + part * 2048 + c0 + seg * 8); }
    __syncthreads();
#pragma unroll
    for (int ps = 0; ps < 2; ++ps) { const int tok = (tid >> 4) + 32 * ps, seg = tid & 15;
        float r[3][8];
#pragma unroll
        for (int part = 0; part < 3; ++part) {
            const LAS bf16_t* base = X0 + part * 64 * 136 + tok * 136 + seg * 8;
            const u32x4 cur = *(const LAS u32x4*)base;
            u32x4 prv = (u32x4){0u, 0u, 0u, 0u}, nxt = (u32x4){0u, 0u, 0u, 0u};
            if (tok > 0) prv = *(const LAS u32x4*)(base - 136);
            if (tok < 63) nxt = *(const LAS u32x4*)(base + 136);
            const float* w0 = cw + part * 2048 + c0 + seg * 8;
            const unsigned pw[4] = {prv.x, prv.y, prv.z, prv.w}, cwd[4] = {cur.x, cur.y, cur.z, cur.w}, nw[4] = {nxt.x, nxt.y, nxt.z, nxt.w};
#pragma unroll
            for (int q = 0; q < 4; ++q) {
                r[part][2 * q] = bflo(pw[q]) * w0[2 * q] + bflo(cwd[q]) * w0[6144 + 2 * q] + bflo(nw[q]) * w0[12288 + 2 * q];
                r[part][2 * q + 1] = bfhi(pw[q]) * w0[2 * q + 1] + bfhi(cwd[q]) * w0[6144 + 2 * q + 1] + bfhi(nw[q]) * w0[12288 + 2 * q + 1]; }
        }
        u32x4 w; w.x = pk2(r[0][0], r[0][1]); w.y = pk2(r[0][2], r[0][3]); w.z = pk2(r[0][4], r[0][5]); w.w = pk2(r[0][6], r[0][7]);
        *(u32x4*)(P + (size_t)tok * 6144 + c0 + seg * 8) = w;
#pragma unroll
        for (int e = 0; e < 8; ++e) ZT[(seg * 8 + e) * 72 + tok] = f2bf(r[1][e] * r[2][e]);
    }
    __syncthreads();
    const int b = rr >> 6, t0 = (rr & 63) * 64;
    bf16_t* zT = (bf16_t*)(p.ws + OFF_BIG);
#pragma unroll
    for (int ps = 0; ps < 2; ++ps) { const int ch = (tid >> 3) + 64 * ps, ts = (tid & 7) * 8;
        *(u32x4*)(zT + ((size_t)(c0 + ch) * 4 + b) * 4096 + t0 + ts) = *(const LAS u32x4*)(ZT + ch * 72 + ts); }
}
DI void hyconv_pipe(const Params& p, LAS unsigned char* lds, int bid, int G) {
    LAS bf16_t* X0 = (LAS bf16_t*)lds;
    LAS bf16_t* ZT = X0 + 3 * 64 * 136;
    const int tid = tidx(), seg = tid & 15, tk0 = tid >> 4;
    int u = bid; if (u >= 4096) return;
    bf16_t* Pb = (bf16_t*)(p.ws + OFF_X);
    bf16_t* zT = (bf16_t*)(p.ws + OFF_BIG);
    u32x4 pa[6], pb[6];
#define HY_LOAD(dst, it) do { const bf16_t* P_ = Pb + (size_t)((it) >> 4) * 64 * 6144 + ((it) & 15) * 128; \
        _Pragma("unroll") for (int part = 0; part < 3; ++part) _Pragma("unroll") for (int ps = 0; ps < 2; ++ps) \
            dst[part * 2 + ps] = *(const u32x4*)(P_ + (size_t)(tk0 + 32 * ps) * 6144 + part * 2048 + seg * 8); } while (0)
    HY_LOAD(pa, u);
    if (u + G < 4096) HY_LOAD(pb, u + G);
    __syncthreads();
    for (;;) {
        const int rr = u >> 4, c0 = (u & 15) * 128;
        bf16_t* P = Pb + (size_t)rr * 64 * 6144;
        f32x4 wv[3][3][2];
#pragma unroll
        for (int part = 0; part < 3; ++part)
#pragma unroll
            for (int k = 0; k < 3; ++k) { const float* wp = p.in[9] + k * 6144 + part * 2048 + c0 + seg * 8; wv[part][k][0] = *(const f32x4*)wp; wv[part][k][1] = *(const f32x4*)(wp + 4); }
        LDS_BARRIER();
#pragma unroll
        for (int part = 0; part < 3; ++part)
#pragma unroll
            for (int ps = 0; ps < 2; ++ps) { *(LAS u32x4*)(X0 + part * 64 * 136 + (tk0 + 32 * ps) * 136 + seg * 8) = pa[part * 2 + ps]; pa[part * 2 + ps] = pb[part * 2 + ps]; }
        if (u + 2 * G < 4096) HY_LOAD(pb, u + 2 * G);
        LDS_BARRIER();
#pragma unroll
        for (int ps = 0; ps < 2; ++ps) { const int tok = tk0 + 32 * ps;
            float r[3][8];
#pragma unroll
            for (int part = 0; part < 3; ++part) {
                const LAS bf16_t* base = X0 + part * 64 * 136 + tok * 136 + seg * 8;
                const u32x4 cur = *(const LAS u32x4*)base;
                u32x4 prv = (u32x4){0u, 0u, 0u, 0u}, nxt = (u32x4){0u, 0u, 0u, 0u};
                if (tok > 0) prv = *(const LAS u32x4*)(base - 136);
                if (tok < 63) nxt = *(const LAS u32x4*)(base + 136);
                const unsigned pw[4] = {prv.x, prv.y, prv.z, prv.w}, cwd[4] = {cur.x, cur.y, cur.z, cur.w}, nw[4] = {nxt.x, nxt.y, nxt.z, nxt.w};
#pragma unroll
                for (int q = 0; q < 4; ++q) { const int h2 = q >> 1, e0 = (2 * q) & 3;
                    r[part][2 * q] = bflo(pw[q]) * wv[part][0][h2][e0] + bflo(cwd[q]) * wv[part][1][h2][e0] + bflo(nw[q]) * wv[part][2][h2][e0];
                    r[part][2 * q + 1] = bfhi(pw[q]) * wv[part][0][h2][e0 + 1] + bfhi(cwd[q]) * wv[part][1][h2][e0 + 1] + bfhi(nw[q]) * wv[part][2][h2][e0 + 1]; }
            }
            u32x4 w; w.x = pk2(r[0][0], r[0][1]); w.y = pk2(r[0][2], r[0][3]); w.z = pk2(r[0][4], r[0][5]); w.w = pk2(r[0][6], r[0][7]);
            *(u32x4*)(P + (size_t)tok * 6144 + c0 + seg * 8) = w;
            const int tsw = (((tok >> 2) ^ seg) << 2) + (tok & 3);
#pragma unroll
            for (int e = 0; e < 8; ++e) ZT[(seg * 8 + e) * 72 + tsw] = f2bf(r[1][e] * r[2][e]);
        }
        LDS_BARRIER();
        const int b = rr >> 6, t0 = (rr & 63) * 64;
#pragma unroll
        for (int ps = 0; ps < 2; ++ps) { const int ch = (tid >> 3) + 64 * ps, tsb = tid & 7, sg = ch >> 3;
            const u32x4 v = *(const LAS u32x4*)(ZT + ch * 72 + ((tsb ^ (sg >> 1)) << 3));
            const u32x4 o = (sg & 1) ? (u32x4){v.z, v.w, v.x, v.y} : v;
            *(u32x4*)(zT + ((size_t)(c0 + ch) * 4 + b) * 4096 + t0 + tsb * 8) = o; }
        u += G;
        if (u >= 4096) break;
    }
#undef HY_LOAD
    __syncthreads();
}
constexpr int LC_ZB = 6336, LC_ZP = 80;
constexpr int LC_Q = 0, LC_ZS = 65536, LC_G = LC_ZS + 4 * LC_ZB * 2, LC_END = LC_G + 8200 * 2;
DI void longconv_init(LAS unsigned char* lds) {
    LAS bf16_t* ZS = (LAS bf16_t*)(lds + LC_ZS);
    LAS bf16_t* Gt = (LAS bf16_t*)(lds + LC_G);
    __syncthreads();
    for (int i = tidx(); i < 4 * LC_ZB; i += NTHREADS) ZS[i] = 0;
    if (tidx() < 8) { Gt[8192 + tidx()] = 0; }
    if (tidx() == 8) Gt[0] = 0;
    __syncthreads();
}
DI void lds_rd64(u32x2& d, unsigned addr) { asm volatile("ds_read_b64 %0, %1" : "=v"(d) : "v"(addr)); }
DI void lds_rd64o(u32x2& d, unsigned addr) { asm volatile("ds_read_b64 %0, %1 offset:32" : "=v"(d) : "v"(addr)); }
DI void lds_rd128(u32x4& d, unsigned addr, int) { asm volatile("ds_read_b128 %0, %1" : "=v"(d) : "v"(addr)); }
struct LcFrags { u32x2 a[6][2]; u32x4 b[4]; };
DI void lc_load(LcFrags& f, unsigned qaddr, unsigned baddr) {
#pragma unroll
    for (int i = 0; i < 6; ++i) { lds_rd64(f.a[i][0], qaddr + (unsigned)(16 * i - 48) * 8u); lds_rd64o(f.a[i][1], qaddr + (unsigned)(16 * i - 48) * 8u); }
#pragma unroll
    for (int lb2 = 0; lb2 < 2; ++lb2)
#pragma unroll
        for (int cg = 0; cg < 2; ++cg) lds_rd128(f.b[lb2 * 2 + cg], baddr + 64u * lb2 + (unsigned)(cg * 4 * LC_ZP * 2), 0);
}
DI void lc_wait(LcFrags& f) {
    asm volatile("s_waitcnt lgkmcnt(0)" : "+v"(f.a[0][0]), "+v"(f.a[0][1]), "+v"(f.a[1][0]), "+v"(f.a[1][1]), "+v"(f.a[2][0]), "+v"(f.a[2][1]),
                 "+v"(f.a[3][0]), "+v"(f.a[3][1]), "+v"(f.a[4][0]), "+v"(f.a[4][1]), "+v"(f.a[5][0]), "+v"(f.a[5][1]) :: "memory");
    asm volatile("" : "+v"(f.b[0]), "+v"(f.b[1]), "+v"(f.b[2]), "+v"(f.b[3]) :: "memory");
}
DI bf16x8 lc_a(const LcFrags& f, int i) { union { u32x2 h[2]; bf16x8 v; } u; u.h[0] = f.a[i][0]; u.h[1] = f.a[i][1]; return u.v; }
DI void longconv_pipe(const Params& p, LAS unsigned char* lds, int bid, int G) {
    LAS unsigned long long* Q = (LAS unsigned long long*)(lds + LC_Q);
    LAS bf16_t* ZS = (LAS bf16_t*)(lds + LC_ZS);
    LAS bf16_t* Gt = (LAS bf16_t*)(lds + LC_G);
    const int tid = tidx(), lane = tid & 63, w = tid >> 6;
    int c = bid; if (c >= 2048) return;
    u32x4 ptf, ptb, pz[4]; float pbias;
#define LC_PREFETCH(cc) do { const bf16_t* tp_ = (const bf16_t*)(p.ws + OFF_TAPS) + (size_t)(cc) * 8192; const bf16_t* zp_ = (const bf16_t*)(p.ws + OFF_BIG) + (size_t)(cc) * 4 * 4096; \
        ptf = *(const u32x4*)(tp_ + tid * 8); ptb = *(const u32x4*)(tp_ + 4096 + tid * 8); pbias = p.in[10][(cc)]; \
        _Pragma("unroll") for (int ps = 0; ps < 4; ++ps) { const int e_ = tid + ps * NTHREADS; pz[ps] = *(const u32x4*)(zp_ + (size_t)(e_ >> 9) * 4096 + (e_ & 511) * 8); } } while (0)
    LC_PREFETCH(c);
    __syncthreads();
  for (;;) {
    const float bias = pbias;
    LDS_BARRIER();
    {
        const u32x4 tf = ptf;
        u32x4 tb = ptb;
        if (tid == 0) tb.x = (tb.x & 0xffff0000u) | (tf.x & 0xffffu);
        *(LAS u32x4*)(Gt + 4096 + tid * 8) = tb;
        const unsigned fw[4] = {tf.x, tf.y, tf.z, tf.w};
#pragma unroll
        for (int q = 0; q < 4; ++q) { if (tid > 0 || q > 0) Gt[4096 - (tid * 8 + 2 * q)] = (bf16_t)(fw[q] & 0xffffu); Gt[4096 - (tid * 8 + 2 * q + 1)] = (bf16_t)(fw[q] >> 16); }
    }
#pragma unroll
    for (int ps = 0; ps < 4; ++ps) { const int e = tid + ps * NTHREADS, b = e >> 9, s = (e & 511) * 8, k = s >> 6, l = s & 63;
        *(LAS u32x4*)(ZS + b * LC_ZB + (k + 7) * LC_ZP + l) = pz[ps]; }
    if (c + G < 2048) LC_PREFETCH(c + G);
    LDS_BARRIER();
#pragma unroll
    for (int ps = 0; ps < 4; ++ps) { const int m = tid + ps * NTHREADS;
        const unsigned long long lo = *(const LAS unsigned long long*)(Gt + 4 * m), hi = *(const LAS unsigned long long*)(Gt + 4 * m + 4);
        Q[4 * m] = lo; Q[4 * m + 1] = (lo >> 16) | (hi << 48); Q[4 * m + 2] = (lo >> 32) | (hi << 32); Q[4 * m + 3] = (lo >> 48) | (hi << 16); }
    LDS_BARRIER();
    const int r16 = lane & 15, q4 = lane >> 4, nb = r16 >> 2, ni = r16 & 3, i0 = 8 * w;
    f32x4 acc[4][2];
#pragma unroll
    for (int jb = 0; jb < 4; ++jb)
#pragma unroll
        for (int cg = 0; cg < 2; ++cg) acc[jb][cg] = (f32x4){0.f, 0.f, 0.f, 0.f};
    const int dlo = i0 - 63, dhi = i0 + 7;
    unsigned qaddr = (unsigned)(LC_Q + (4096 - 64 * dlo - r16 + 8 * q4) * 8);
    unsigned baddr = (unsigned)(LC_ZS + (nb * LC_ZB + (i0 + ni - dlo + 7) * LC_ZP + 8 * q4) * 2);
    LcFrags fa, fb;
    lc_load(fa, qaddr, baddr);
#define LC_STEP(cur, nxt, more, C0, C1) do { \
        lc_wait(cur); \
        qaddr -= 512u; baddr -= (unsigned)(LC_ZP * 2); \
        if (more) lc_load(nxt, qaddr, baddr); \
        _Pragma("unroll") for (int lb2 = 0; lb2 < 2; ++lb2) _Pragma("unroll") for (int jb = 0; jb < 4; ++jb) _Pragma("unroll") for (int cg = 0; cg < 2; ++cg) \
            if ((cg == 0 && (C0)) || (cg == 1 && (C1))) \
                acc[jb][cg] = __builtin_amdgcn_mfma_f32_16x16x32_bf16(lc_a(cur, 3 - jb + 2 * lb2), __builtin_bit_cast(bf16x8, cur.b[lb2 * 2 + cg]), acc[jb][cg], 0, 0, 0); } while (0)
    LC_STEP(fa, fb, true, true, false); LC_STEP(fb, fa, true, true, false); LC_STEP(fa, fb, true, true, false); LC_STEP(fb, fa, true, true, false);
#pragma unroll 1
    for (int it = 0; it < 31; ++it) { LC_STEP(fa, fb, true, true, true); LC_STEP(fb, fa, true, true, true); }
    LC_STEP(fa, fb, true, true, true);
    LC_STEP(fb, fa, true, false, true); LC_STEP(fa, fb, true, false, true); LC_STEP(fb, fa, true, false, true); LC_STEP(fa, fb, false, false, true);
#undef LC_STEP
#pragma unroll
    for (int cg = 0; cg < 2; ++cg) { const int ib = i0 + 4 * cg + ni;
        bf16_t* yT = (bf16_t*)(p.ws + OFF_BIG + SZ67) + ((size_t)c * 4 + nb) * 4096 + 64 * ib;
        const LAS bf16_t* zrow = ZS + nb * LC_ZB + (ib + 7) * LC_ZP;
#pragma unroll
        for (int jb = 0; jb < 4; ++jb) { const int j = 16 * jb + 4 * q4; float o[4];
#pragma unroll
            for (int e = 0; e < 4; ++e) o[e] = acc[jb][cg][e] + bias * bf2f(zrow[j + e]);
            u32x2 wv; wv.x = pk2(o[0], o[1]); wv.y = pk2(o[2], o[3]);
            *(u32x2*)(yT + j) = wv; } }
    c += G; if (c >= 2048) break;
  }
#undef LC_PREFETCH
    __syncthreads();
}
DI void job_hmix(const Params& p, int item, LAS unsigned char* lds) {
    LAS bf16_t* T = (LAS bf16_t*)lds;
    const int tid = tidx(), rr = item >> 4, cb = item & 15, c0 = cb * 128, b = rr >> 6, t0 = (rr & 63) * 64;
    const bf16_t* yT = (const bf16_t*)(p.ws + OFF_BIG + SZ67);
    __syncthreads();
#pragma unroll
    for (int ps = 0; ps < 2; ++ps) { const int ch = (tid >> 3) + 64 * ps, ts = (tid & 7) * 8;
        const u32x4 v = *(const u32x4*)(yT + ((size_t)(c0 + ch) * 4 + b) * 4096 + t0 + ts);
        LAS unsigned* dp = (LAS unsigned*)(T + ch * 66 + ts); dp[0] = v.x; dp[1] = v.y; dp[2] = v.z; dp[3] = v.w; }
    __syncthreads();
    const bf16_t* P = (const bf16_t*)(p.ws + OFF_X) + (size_t)rr * 64 * 6144;
    bf16_t* HM = (bf16_t*)(p.ws + OFF_BIG + 2 * SZ67) + (size_t)rr * 64 * 2048;
#pragma unroll
    for (int ps = 0; ps < 2; ++ps) { const int tok = (tid >> 4) + 32 * ps, seg = tid & 15;
        const u32x4 xv = *(const u32x4*)(P + (size_t)tok * 6144 + c0 + seg * 8);
        float y[8];
#pragma unroll
        for (int e = 0; e < 8; ++e) y[e] = bf2f(T[(seg * 8 + e) * 66 + tok]);
        u32x4 w; w.x = pk2(bflo(xv.x) * y[0], bfhi(xv.x) * y[1]); w.y = pk2(bflo(xv.y) * y[2], bfhi(xv.y) * y[3]);
        w.z = pk2(bflo(xv.z) * y[4], bfhi(xv.z) * y[5]); w.w = pk2(bflo(xv.w) * y[6], bfhi(xv.w) * y[7]);
        *(u32x4*)(HM + (size_t)tok * 2048 + c0 + seg * 8) = w; }
}
DI void hmix_pipe(const Params& p, LAS unsigned char* lds, int bid, int G) {
    LAS bf16_t* T = (LAS bf16_t*)lds;
    const int tid = tidx(), seg = tid & 15, tk0 = tid >> 4;
    int u = bid; if (u >= 4096) return;
    const bf16_t* yT = (const bf16_t*)(p.ws + OFF_BIG + SZ67);
    const bf16_t* Pb = (const bf16_t*)(p.ws + OFF_X);
    bf16_t* HMb = (bf16_t*)(p.ws + OFF_BIG + 2 * SZ67);
    u32x4 ya[2], yb[2], xa[2], xb[2];
#define HM_LOAD(Y, X, it) do { const int rr_ = (it) >> 4, c0_ = ((it) & 15) * 128, b_ = rr_ >> 6, t0_ = (rr_ & 63) * 64; \
        _Pragma("unroll") for (int ps = 0; ps < 2; ++ps) { const int ch_ = (tid >> 3) + 64 * ps; \
            Y[ps] = *(const u32x4*)(yT + ((size_t)(c0_ + ch_) * 4 + b_) * 4096 + t0_ + (tid & 7) * 8); \
            X[ps] = *(const u32x4*)(Pb + ((size_t)rr_ * 64 + tk0 + 32 * ps) * 6144 + c0_ + seg * 8); } } while (0)
    HM_LOAD(ya, xa, u);
    if (u + G < 4096) HM_LOAD(yb, xb, u + G);
    __syncthreads();
    for (;;) {
        const int rr = u >> 4, c0 = (u & 15) * 128;
        LDS_BARRIER();
        u32x4 xc[2];
#pragma unroll
        for (int ps = 0; ps < 2; ++ps) { const int ch = (tid >> 3) + 64 * ps, tsb = tid & 7, sg = ch >> 3;
            const u32x4 v = ya[ps]; const u32x4 o = (sg & 1) ? (u32x4){v.z, v.w, v.x, v.y} : v;
            *(LAS u32x4*)(T + ch * 72 + ((tsb ^ (sg >> 1)) << 3)) = o;
            xc[ps] = xa[ps]; ya[ps] = yb[ps]; xa[ps] = xb[ps]; }
        if (u + 2 * G < 4096) HM_LOAD(yb, xb, u + 2 * G);
        LDS_BARRIER();
#pragma unroll
        for (int ps = 0; ps < 2; ++ps) { const int tok = tk0 + 32 * ps;
            const u32x4 xv = xc[ps];
            const int tsw = (((tok >> 2) ^ seg) << 2) + (tok & 3);
            float y[8];
#pragma unroll
            for (int e = 0; e < 8; ++e) y[e] = bf2f(T[(seg * 8 + e) * 72 + tsw]);
            u32x4 w; w.x = pk2(bflo(xv.x) * y[0], bfhi(xv.x) * y[1]); w.y = pk2(bflo(xv.y) * y[2], bfhi(xv.y) * y[3]);
            w.z = pk2(bflo(xv.z) * y[4], bfhi(xv.z) * y[5]); w.w = pk2(bflo(xv.w) * y[6], bfhi(xv.w) * y[7]);
            *(u32x4*)(HMb + ((size_t)rr * 64 + tok) * 2048 + c0 + seg * 8) = w; }
        u += G;
        if (u >= 4096) break;
    }
#undef HM_LOAD
    __syncthreads();
}
DI void job_scal(const Params& p, int item) {
    float* SC = (float*)(p.ws + OFF_SC) + (size_t)item * 2048 + tidx() * 4;
    const int c0 = (tidx() * 4) & 63;
    f32x4 v = *(const f32x4*)SC;
#pragma unroll
    for (int j = 0; j < 4; ++j) { const int c = c0 + j; const float x = v[j];
        if (c < 32) v[j] = 1.0f / (1.0f + expf(-x));
        else { const float y = x + p.in[21][c - 32]; const float sp = fmaxf(y, 0.f) + log1pf(expf(-fabsf(y))); v[j] = -expf(p.in[20][c - 32]) * sp; } }
    *(f32x4*)SC = v;
}
DI void job_qkvconv(const Params& p, int item, LAS unsigned char* lds) {
    LAS bf16_t* T = (LAS bf16_t*)lds;
    const int tid = tidx();
    int row0, ntok, cbk;
    if (item < 12288) { row0 = (item / 48) * 64; ntok = 64; cbk = item % 48; }
    else { const int it = item - 12288; row0 = NTOK + (it / 48) * 256; ntok = 256; cbk = it % 48; }
    bf16_t* P = (bf16_t*)(p.ws + OFF_BIG) + (size_t)row0 * 6144 + cbk * 128;
    const float* cw = p.in[19] + cbk * 128;
    __syncthreads();
    for (int e = tid; e < ntok * 16; e += NTHREADS) { const int tok = e >> 4, seg = e & 15; *(LAS u32x4*)(T + tok * 136 + seg * 8) = *(const u32x4*)(P + (size_t)tok * 6144 + seg * 8); }
    __syncthreads();
    for (int e = tid; e < ntok * 16; e += NTHREADS) { const int tok = e >> 4, seg = e & 15;
        const LAS bf16_t* base = T + tok * 136 + seg * 8;
        const u32x4 cur = *(const LAS u32x4*)base;
        u32x4 prv = (u32x4){0u, 0u, 0u, 0u}, nxt = (u32x4){0u, 0u, 0u, 0u};
        if (tok > 0) prv = *(const LAS u32x4*)(base - 136);
        if (tok < ntok - 1) nxt = *(const LAS u32x4*)(base + 136);
        const float* w0 = cw + seg * 8;
        const unsigned pw[4] = {prv.x, prv.y, prv.z, prv.w}, cwd[4] = {cur.x, cur.y, cur.z, cur.w}, nw[4] = {nxt.x, nxt.y, nxt.z, nxt.w};
        float r[8]; float ss = 0.f;
#pragma unroll
        for (int q = 0; q < 4; ++q) {
            float a = bflo(pw[q]) * w0[2 * q] + bflo(cwd[q]) * w0[6144 + 2 * q] + bflo(nw[q]) * w0[12288 + 2 * q];
            float bq = bfhi(pw[q]) * w0[2 * q + 1] + bfhi(cwd[q]) * w0[6144 + 2 * q + 1] + bfhi(nw[q]) * w0[12288 + 2 * q + 1];
            a = siluf_(a); bq = siluf_(bq); r[2 * q] = a; r[2 * q + 1] = bq; ss += a * a + bq * bq; }
        if (cbk < 32) {
            ss += __shfl_xor(ss, 1); ss += __shfl_xor(ss, 2); ss += __shfl_xor(ss, 4); ss += __shfl_xor(ss, 8);
            const float sc = __builtin_amdgcn_rsqf(ss + 1e-6f);
#pragma unroll
            for (int q = 0; q < 8; ++q) r[q] *= sc; }
        u32x4 w; w.x = pk2(r[0], r[1]); w.y = pk2(r[2], r[3]); w.z = pk2(r[4], r[5]); w.w = pk2(r[6], r[7]);
        *(u32x4*)(P + (size_t)tok * 6144 + seg * 8) = w; }
}
DI void qkvconv_latent_pipe(const Params& p, LAS unsigned char* lds, int bid, int G) {
    LAS bf16_t* T = (LAS bf16_t*)lds;
    const int tid = tidx(), seg = tid & 15, tk0 = tid >> 4;
    int u = bid; if (u >= 12288) return;
    bf16_t* Pb = (bf16_t*)(p.ws + OFF_BIG);
    u32x4 pa[2], pb[2];
#define QKV_ITEM_PTR(it) (Pb + (size_t)((it) / 48) * 64 * 6144 + ((it) % 48) * 128)
#define QKV_LOAD(dst, it) do { const bf16_t* P_ = QKV_ITEM_PTR(it); _Pragma("unroll") for (int ps = 0; ps < 2; ++ps) dst[ps] = *(const u32x4*)(P_ + (size_t)(tk0 + 32 * ps) * 6144 + seg * 8); } while (0)
    QKV_LOAD(pa, u);
    if (u + G < 12288) QKV_LOAD(pb, u + G);
    __syncthreads();
    for (;;) {
        const int cbk = u % 48;
        bf16_t* P = QKV_ITEM_PTR(u);
        f32x4 wv[3][2];
#pragma unroll
        for (int k = 0; k < 3; ++k) { wv[k][0] = *(const f32x4*)(p.in[19] + k * 6144 + cbk * 128 + seg * 8); wv[k][1] = *(const f32x4*)(p.in[19] + k * 6144 + cbk * 128 + seg * 8 + 4); }
        LDS_BARRIER();
#pragma unroll
        for (int ps = 0; ps < 2; ++ps) { *(LAS u32x4*)(T + (tk0 + 32 * ps) * 136 + seg * 8) = pa[ps]; pa[ps] = pb[ps]; }
        if (u + 2 * G < 12288) QKV_LOAD(pb, u + 2 * G);
        LDS_BARRIER();
#pragma unroll
        for (int ps = 0; ps < 2; ++ps) { const int tok = tk0 + 32 * ps;
            const LAS bf16_t* base = T + tok * 136 + seg * 8;
            const u32x4 cur = *(const LAS u32x4*)base;
            u32x4 prv = (u32x4){0u, 0u, 0u, 0u}, nxt = (u32x4){0u, 0u, 0u, 0u};
            if (tok > 0) prv = *(const LAS u32x4*)(base - 136);
            if (tok < 63) nxt = *(const LAS u32x4*)(base + 136);
            const unsigned pw[4] = {prv.x, prv.y, prv.z, prv.w}, cwd[4] = {cur.x, cur.y, cur.z, cur.w}, nw[4] = {nxt.x, nxt.y, nxt.z, nxt.w};
            float r[8]; float ss = 0.f;
#pragma unroll
            for (int q = 0; q < 4; ++q) { const int h2 = q >> 1, e0 = (2 * q) & 3;
                float a = bflo(pw[q]) * wv[0][h2][e0] + bflo(cwd[q]) * wv[1][h2][e0] + bflo(nw[q]) * wv[2][h2][e0];
                float bq = bfhi(pw[q]) * wv[0][h2][e0 + 1] + bfhi(cwd[q]) * wv[1][h2][e0 + 1] + bfhi(nw[q]) * wv[2][h2][e0 + 1];
                a = siluf_(a); bq = siluf_(bq); r[2 * q] = a; r[2 * q + 1] = bq; ss += a * a + bq * bq; }
            if (cbk < 32) {
                ss += __shfl_xor(ss, 1); ss += __shfl_xor(ss, 2); ss += __shfl_xor(ss, 4); ss += __shfl_xor(ss, 8);
                const float sc = __builtin_amdgcn_rsqf(ss + 1e-6f);
#pragma unroll
                for (int q = 0; q < 8; ++q) r[q] *= sc; }
            u32x4 w; w.x = pk2(r[0], r[1]); w.y = pk2(r[2], r[3]); w.z = pk2(r[4], r[5]); w.w = pk2(r[6], r[7]);
            *(u32x4*)(P + (size_t)tok * 6144 + seg * 8) = w; }
        u += G;
        if (u >= 12288) break;
    }
#undef QKV_ITEM_PTR
#undef QKV_LOAD
    __syncthreads();
}
DI bf16x8 pack_acc(const f32x16& x, int s) {
    u32x4 q; q.x = pk2(x[8 * s], x[8 * s + 1]); q.y = pk2(x[8 * s + 2], x[8 * s + 3]); q.z = pk2(x[8 * s + 4], x[8 * s + 5]); q.w = pk2(x[8 * s + 6], x[8 * s + 7]);
    return __builtin_bit_cast(bf16x8, q);
}
DI bf16x8 read_perm(const LAS bf16_t* base, int pitch, int row, int col0, int hh) {
    const LAS bf16_t* q = base + row * pitch + col0 + 4 * hh;
    union { u32x2 h[2]; bf16x8 v; } u; u.h[0] = *(const LAS u32x2*)q; u.h[1] = *(const LAS u32x2*)(q + 8); return u.v;
}
DI bf16x8 read_perm_sw(const LAS bf16_t* base, int row, int col0, int hh) {
    const int sw = (row >> 3) & 15, g0 = (col0 >> 2) + hh;
    const LAS bf16_t* q = base + row * 72;
    union { u32x2 h[2]; bf16x8 v; } u; u.h[0] = *(const LAS u32x2*)(q + ((g0 ^ sw) << 2)); u.h[1] = *(const LAS u32x2*)(q + (((g0 + 2) ^ sw) << 2)); return u.v;
}
DI int scan_row(int n, int tau, int b, int dir) {
    if (n < 4) { const int pz = n * 64 + tau; return NTOK + b * CTXL + (dir ? (CTXL - 1 - pz) : pz); }
    const int pz = (n - 4) * 64 + tau; return b * SEQL + (dir ? (SEQL - 1 - pz) : pz);
}
__host__ __device__ constexpr int tri_off(int t) { return t == 0 ? 0 : 4 * (((t - 1) / 4 + 1) * (2 * ((t - 1) / 4) + ((t - 1) % 4))); }
constexpr int TRI_FLOATS = 2112, PREP_WAVE_BYTES = TRI_FLOATS * 4 + 512 + 32 * 36 * 4;
DI void job_prep_T(const Params& p, int item, LAS unsigned char* lds_wave) {
    LAS float* AP = (LAS float*)lds_wave;
    LAS float* GCw = AP + TRI_FLOATS;
    LAS float* BTw = GCw + 64;
    const int lane = tidx() & 63, r = lane & 31, hh = lane >> 5;
    const int n = item % 68, dir = (item / 68) & 1, h = (item / 136) & 15, b = item / 2176;
    const bf16_t* P = (const bf16_t*)(p.ws + OFF_BIG);
    const float* SCv = (const float*)(p.ws + OFF_SC);
    bf16x8 kf[2][8];
#pragma unroll
    for (int rb = 0; rb < 2; ++rb) { const bf16_t* src = P + (size_t)scan_row(n, 32 * rb + r, b, dir) * 6144 + 2048 + h * 128 + 8 * hh;
#pragma unroll
        for (int ks = 0; ks < 8; ++ks) kf[rb][ks] = *(const bf16x8*)(src + 16 * ks); }
    {
        const int row = scan_row(n, lane, b, dir);
        float g = SCv[(size_t)row * 64 + 32 + dir * 16 + h];
        const float bt = SCv[(size_t)row * 64 + dir * 16 + h];
#pragma unroll
        for (int o = 1; o < 64; o <<= 1) { const float v = __shfl_up(g, o); if (lane >= o) g += v; }
        GCw[lane] = g; BTw[lane] = bt;
        ((float*)(p.ws + OFF_GCG))[(size_t)item * 64 + lane] = g;
    }
    f32x16 a00, a10, a11;
#pragma unroll
    for (int i = 0; i < 16; ++i) { a00[i] = 0.f; a10[i] = 0.f; a11[i] = 0.f; }
#pragma unroll
    for (int ks = 0; ks < 8; ++ks) { a00 = MFMA32(kf[0][ks], kf[0][ks], a00); a10 = MFMA32(kf[1][ks], kf[0][ks], a10); a11 = MFMA32(kf[1][ks], kf[1][ks], a11); }
    {
        const float gs0 = GCw[r], gs1 = GCw[32 + r];
#pragma unroll
        for (int i = 0; i < 16; ++i) { const int t0 = crow(i, hh), t1 = 32 + t0; const float g0 = GCw[t0], g1 = GCw[t1], b0 = BTw[t0], b1 = BTw[t1];
            if (r < t0) AP[tri_off(t0) + r] = a00[i] * b0 * __expf(g0 - gs0);
            AP[tri_off(t1) + r] = a10[i] * b1 * __expf(g1 - gs0);
            if (r < t0) AP[tri_off(t1) + 32 + r] = a11[i] * b1 * __expf(g1 - gs1); }
    }
    bf16_t* TG = (bf16_t*)(p.ws + OFF_TMG) + (size_t)item * 3072;
    LAS float* TL = BTw + 64;
    float Tc[32];
#pragma unroll
    for (int t = 0; t < 32; ++t) {
        float a[4] = {(r == t) ? 1.f : 0.f, 0.f, 0.f, 0.f};
        const LAS float* arow = AP + (hh ? (tri_off(32 + t) + 32) : tri_off(t));
#pragma unroll
        for (int s4 = 0; s4 < (t + 3) / 4; ++s4) { const f32x4 av = *(const LAS f32x4*)(arow + 4 * s4);
#pragma unroll
            for (int e = 0; e < 4; ++e) if (4 * s4 + e < t) a[e] -= av[e] * Tc[4 * s4 + e]; }
        Tc[t] = (a[0] + a[1]) + (a[2] + a[3]);
        TG[2048 * hh + t * 32 + r] = f2bf(Tc[t]);
        if (hh) TL[t * 36 + r] = Tc[t];
    }
    f32x16 W;
#pragma unroll
    for (int i = 0; i < 16; ++i) W[i] = 0.f;
    {
        const LAS float* a10 = AP + tri_off(32 + r) + 8 * hh;
#pragma unroll
        for (int ks = 0; ks < 2; ++ks) {
            const f32x4 x0 = *(const LAS f32x4*)(a10 + 16 * ks), x1 = *(const LAS f32x4*)(a10 + 16 * ks + 4);
            u32x4 qa; qa.x = pk2(x0[0], x0[1]); qa.y = pk2(x0[2], x0[3]); qa.z = pk2(x1[0], x1[1]); qa.w = pk2(x1[2], x1[3]);
            float bsel[8];
#pragma unroll
            for (int j = 0; j < 8; ++j) { const float up = __shfl_xor(Tc[16 * ks + 8 + j], 32); bsel[j] = hh ? up : Tc[16 * ks + j]; }
            u32x4 qb; qb.x = pk2(bsel[0], bsel[1]); qb.y = pk2(bsel[2], bsel[3]); qb.z = pk2(bsel[4], bsel[5]); qb.w = pk2(bsel[6], bsel[7]);
            W = MFMA32(__builtin_bit_cast(bf16x8, qa), __builtin_bit_cast(bf16x8, qb), W);
        }
    }
    f32x16 T10;
#pragma unroll
    for (int i = 0; i < 16; ++i) T10[i] = 0.f;
#pragma unroll
    for (int sx = 0; sx < 2; ++sx) {
        const LAS float* tr = TL + r * 36 + 16 * sx + 4 * hh;
        const f32x4 x0 = *(const LAS f32x4*)tr, x1 = *(const LAS f32x4*)(tr + 8);
        u32x4 qa; qa.x = pk2(x0[0], x0[1]); qa.y = pk2(x0[2], x0[3]); qa.z = pk2(x1[0], x1[1]); qa.w = pk2(x1[2], x1[3]);
        T10 = MFMA32(__builtin_bit_cast(bf16x8, qa), pack_acc(W, sx), T10);
    }
#pragma unroll
    for (int i = 0; i < 16; ++i) TG[1024 + crow(i, hh) * 32 + r] = f2bf(-T10[i]);
}
constexpr int SC_QN = 0, SC_KN = 17408, SC_VN = 34816, SC_KT = 52224, SC_TM = 70656, SC_QK = 78336, SC_OST = 87552, SC_GC = 104960, SC_BT = 105216, SC_EG = 105472, SC_EK = 105728;
struct FB4 { u32x2 h[4][2]; };
DI void fb_rd(FB4& f, int i, unsigned a0, unsigned a1) { asm volatile("ds_read_b64 %0, %1" : "=v"(f.h[i][0]) : "v"(a0)); asm volatile("ds_read_b64 %0, %1" : "=v"(f.h[i][1]) : "v"(a1)); }
DI void fb_wait(FB4& f) {
    asm volatile("s_waitcnt lgkmcnt(0)" : "+v"(f.h[0][0]), "+v"(f.h[0][1]), "+v"(f.h[1][0]), "+v"(f.h[1][1]), "+v"(f.h[2][0]), "+v"(f.h[2][1]), "+v"(f.h[3][0]), "+v"(f.h[3][1]) :: "memory");
}
DI bf16x8 fb_get(const FB4& f, int i) { union { u32x2 h[2]; bf16x8 v; } u; u.h[0] = f.h[i][0]; u.h[1] = f.h[i][1]; return u.v; }
DI void fb_issue_nat(FB4& f, unsigned base, int kb) {
#pragma unroll
    for (int s = 0; s < 2; ++s)
#pragma unroll
        for (int tb = 0; tb < 2; ++tb) { const unsigned a = base + (unsigned)(tb * 32 * 272 + (32 * kb + 16 * s) * 2); fb_rd(f, 2 * s + tb, a, a + 16u); }
}
DI void fb_rd_tr(FB4& f, int i, unsigned a0, unsigned a1) { asm volatile("ds_read_b64_tr_b16 %0, %1" : "=v"(f.h[i][0]) : "v"(a0)); asm volatile("ds_read_b64_tr_b16 %0, %1" : "=v"(f.h[i][1]) : "v"(a1)); }
DI void fb_issue_kt(FB4& f, int kp, int s, int lane) {
    const int li = lane & 15, q = li >> 2, pp = li & 3, gcol = (lane >> 4) & 1, hh = lane >> 5;
#pragma unroll
    for (int kk = 0; kk < 2; ++kk)
#pragma unroll
        for (int half = 0; half < 2; ++half) { const int tau0 = 32 * half + 16 * s + 4 * hh + q, dk = 32 * (2 * kp + kk) + 16 * gcol + 4 * pp;
            const unsigned a = (unsigned)(SC_KN + (tau0 * 136 + dk) * 2); fb_rd_tr(f, 2 * kk + half, a, a + 8u * 272u); }
}
DI void fb_issue_tri(FB4& f, unsigned a00, unsigned a10, unsigned a11, int s) {
    fb_rd(f, 0, a00 + 32u * s, a00 + 32u * s + 16u); fb_rd(f, 1, a10 + 32u * s, a10 + 32u * s + 16u); fb_rd(f, 2, a11 + 32u * s, a11 + 32u * s + 16u); fb_rd(f, 3, a00 + 32u * s, a00 + 32u * s + 16u);
}
DI void job_scan(const Params& p, int item, LAS unsigned char* lds) {
    LAS bf16_t* QN = (LAS bf16_t*)(lds + SC_QN);
    LAS bf16_t* KN = (LAS bf16_t*)(lds + SC_KN);
    LAS bf16_t* VN = (LAS bf16_t*)(lds + SC_VN);
    LAS bf16_t* TM = (LAS bf16_t*)(lds + SC_TM);
    LAS bf16_t* QK = (LAS bf16_t*)(lds + SC_QK);
    LAS bf16_t* OST = (LAS bf16_t*)(lds + SC_OST);
    LAS float* GC = (LAS float*)(lds + SC_GC);
    LAS float* BT = (LAS float*)(lds + SC_BT);
    LAS float* EG = (LAS float*)(lds + SC_EG);
    LAS float* EK = (LAS float*)(lds + SC_EK);
    const int tid0 = tidx(), w = __builtin_amdgcn_readfirstlane(tid0 >> 6);
    const int b = item >> 5, h = (item >> 1) & 15, dir = item & 1;
    const bf16_t* P = (const bf16_t*)(p.ws + OFF_BIG);
    const float* SCv = (const float*)(p.ws + OFF_SC);
    const bf16_t* TG = (const bf16_t*)(p.ws + OFF_TMG) + (size_t)item * 68 * 3072;
    const float* GCGv = (const float*)(p.ws + OFF_GCG) + (size_t)item * 68 * 64;
    bf16_t* O = (bf16_t*)p.out + (dir ? (size_t)NTOK * D : 0);
    const float qscale = 0.08838834764831845f;
    f32x16 S[4];
#pragma unroll
    for (int kb = 0; kb < 4; ++kb)
#pragma unroll
        for (int i = 0; i < 16; ++i) S[kb][i] = 0.f;
    int tid = tid0, lane = tid0 & 63, r = lane & 31, hh = lane >> 5;
    u32x4 pq[2], pk[2], pv[2], pt = (u32x4){0u, 0u, 0u, 0u}; float pg = 0.f, pb = 0.f;
#define SCAN_PREFETCH(nn) do { _Pragma("unroll") for (int ps = 0; ps < 2; ++ps) { const int tau_ = (tid >> 4) + 32 * ps, seg_ = tid & 15; \
            const bf16_t* src_ = P + (size_t)scan_row((nn), tau_, b, dir) * 6144 + h * 128 + seg_ * 8; \
            pq[ps] = *(const u32x4*)src_; pk[ps] = *(const u32x4*)(src_ + 2048); pv[ps] = *(const u32x4*)(src_ + 4096); } \
        if (tid < 384) pt = *(const u32x4*)(TG + (size_t)(nn) * 3072 + tid * 8); \
        if (w == 0) { const int row_ = scan_row((nn), lane, b, dir); pg = GCGv[(size_t)(nn) * 64 + lane]; pb = SCv[(size_t)row_ * 64 + dir * 16 + h]; } } while (0)
    SCAN_PREFETCH(0);
#pragma unroll 1
    for (int n = 0; n < 68; ++n) {
        tid = tid0; asm volatile("" : "+v"(tid));
        lane = tid & 63; r = lane & 31; hh = lane >> 5;
        LDS_BARRIER();
        if (w == 0) {
            const float g = pg;
            const float gl = __builtin_bit_cast(float, __builtin_amdgcn_readlane(__builtin_bit_cast(int, g), 63));
            GC[lane] = g; BT[lane] = pb; EG[lane] = __expf(g); EK[lane] = __expf(gl - g);
        }
#pragma unroll
        for (int ps = 0; ps < 2; ++ps) { const int tau = (tid >> 4) + 32 * ps, seg = tid & 15;
            if (n >= 5) *(u32x4*)(O + (size_t)scan_row(n - 1, tau, b, dir) * 2048 + h * 128 + seg * 8) = *(const LAS u32x4*)(OST + tau * 136 + seg * 8);
            *(LAS u32x4*)(QN + tau * 136 + seg * 8) = pq[ps];
            *(LAS u32x4*)(KN + tau * 136 + seg * 8) = pk[ps];
            *(LAS u32x4*)(VN + tau * 136 + seg * 8) = pv[ps];
        }
        if (tid < 384) { const int tile = tid >> 7, row = (tid & 127) >> 2, seg = tid & 3; *(LAS u32x4*)(TM + tile * 1280 + row * 40 + seg * 8) = pt; }
        if (n + 1 < 68) SCAN_PREFETCH(n + 1);
        LDS_BARRIER();
        f32x16 V0, V1;
        const int dv0 = 32 * (w & 3);
        if (w >= 4) {
            if (w < 7) {
                const int tb = (w == 4) ? 0 : 1, sb = (w == 6) ? 1 : 0;
                f32x16 acc;
#pragma unroll
                for (int i = 0; i < 16; ++i) acc[i] = 0.f;
                const LAS bf16_t* Ab = QN + (32 * tb + r) * 136 + 8 * hh;
                const LAS bf16_t* Bb = KN + (32 * sb + r) * 136 + 8 * hh;
                bf16x8 af[8], bfr[8];
#pragma unroll
                for (int ks = 0; ks < 8; ++ks) { af[ks] = *(const LAS bf16x8*)(Ab + 16 * ks); bfr[ks] = *(const LAS bf16x8*)(Bb + 16 * ks); }
                const int s = 32 * sb + r; const float gs = GC[s];
                f32x4 gt4[4];
#pragma unroll
                for (int g4 = 0; g4 < 4; ++g4) gt4[g4] = *(const LAS f32x4*)(GC + 32 * tb + 8 * g4 + 4 * hh);
#pragma unroll
                for (int ks = 0; ks < 8; ++ks) acc = MFMA32(af[ks], bfr[ks], acc);
#pragma unroll
                for (int i = 0; i < 16; ++i) { const int t = 32 * tb + crow(i, hh); const float dg = fminf(gt4[i >> 2][i & 3] - gs, 0.f);
                    const float v = (s <= t) ? acc[i] * qscale * __expf(dg) : 0.f; QK[t * 72 + s] = f2bf(v); }
            }
        } else {
            f32x16 P0, P1;
#pragma unroll
            for (int i = 0; i < 16; ++i) { P0[i] = 0.f; P1[i] = 0.f; V0[i] = 0.f; V1[i] = 0.f; }
            FB4 fa, fb;
            const unsigned knb = (unsigned)(SC_KN + (r * 136 + 4 * hh) * 2);
            const unsigned tm0 = (unsigned)(SC_TM + (r * 40 + 4 * hh) * 2);
            fb_issue_nat(fa, knb, 0);
#define SCAN_P4(F, kb) do { _Pragma("unroll") for (int s_ = 0; s_ < 2; ++s_) { const bf16x8 sf_ = pack_acc(S[kb], s_); \
                P0 = MFMA32(fb_get(F, 2 * s_), sf_, P0); P1 = MFMA32(fb_get(F, 2 * s_ + 1), sf_, P1); } } while (0)
            fb_wait(fa); fb_issue_nat(fb, knb, 1); SCAN_P4(fa, 0);
            fb_wait(fb); fb_issue_nat(fa, knb, 2); SCAN_P4(fb, 1);
            fb_wait(fa); fb_issue_nat(fb, knb, 3); SCAN_P4(fa, 2);
            fb_wait(fb); fb_issue_tri(fa, tm0, tm0 + 2560u, tm0 + 5120u, 0); SCAN_P4(fb, 3);
#undef SCAN_P4
#pragma unroll
            for (int i = 0; i < 16; ++i) { const int t0 = crow(i, hh), t1 = 32 + t0;
                P0[i] = BT[t0] * (bf2f(VN[t0 * 136 + dv0 + r]) - EG[t0] * P0[i]); P1[i] = BT[t1] * (bf2f(VN[t1 * 136 + dv0 + r]) - EG[t1] * P1[i]); }
            fb_wait(fa); fb_issue_tri(fb, tm0, tm0 + 2560u, tm0 + 5120u, 1);
            { const bf16x8 r0 = pack_acc(P0, 0), r1 = pack_acc(P1, 0);
              V0 = MFMA32(fb_get(fa, 0), r0, V0); V1 = MFMA32(fb_get(fa, 1), r0, V1); V1 = MFMA32(fb_get(fa, 2), r1, V1); }
            fb_wait(fb);
            { const bf16x8 r0 = pack_acc(P0, 1), r1 = pack_acc(P1, 1);
              V0 = MFMA32(fb_get(fb, 0), r0, V0); V1 = MFMA32(fb_get(fb, 1), r0, V1); V1 = MFMA32(fb_get(fb, 2), r1, V1); }
        }
        LDS_BARRIER();
        if (w < 4) {
            f32x16 O0, O1;
#pragma unroll
            for (int i = 0; i < 16; ++i) { O0[i] = 0.f; O1[i] = 0.f; }
            FB4 fa, fb;
            const unsigned qnb = (unsigned)(SC_QN + (r * 136 + 4 * hh) * 2);
            const unsigned qk0 = (unsigned)(SC_QK + (r * 72 + 4 * hh) * 2);
            fb_issue_nat(fa, qnb, 0);
#define SCAN_O4(F, kb) do { _Pragma("unroll") for (int s_ = 0; s_ < 2; ++s_) { const bf16x8 sf_ = pack_acc(S[kb], s_); \
                O0 = MFMA32(fb_get(F, 2 * s_), sf_, O0); O1 = MFMA32(fb_get(F, 2 * s_ + 1), sf_, O1); } } while (0)
            fb_wait(fa); fb_issue_nat(fb, qnb, 1); SCAN_O4(fa, 0);
            fb_wait(fb); fb_issue_nat(fa, qnb, 2); SCAN_O4(fb, 1);
            fb_wait(fa); fb_issue_nat(fb, qnb, 3); SCAN_O4(fa, 2);
            fb_wait(fb); fb_issue_tri(fa, qk0, qk0 + 32u * 144u, qk0 + 32u * 144u + 64u, 0); SCAN_O4(fb, 3);
#undef SCAN_O4
#pragma unroll
            for (int i = 0; i < 16; ++i) { O0[i] *= qscale * EG[crow(i, hh)]; O1[i] *= qscale * EG[32 + crow(i, hh)]; }
            const float egl = __expf(GC[63]);
#pragma unroll
            for (int kb = 0; kb < 4; ++kb)
#pragma unroll
                for (int i = 0; i < 16; ++i) S[kb][i] *= egl;
            fb_wait(fa); fb_issue_tri(fb, qk0, qk0 + 32u * 144u, qk0 + 32u * 144u + 64u, 1);
            { const bf16x8 v0 = pack_acc(V0, 0), v1 = pack_acc(V1, 0);
              O0 = MFMA32(fb_get(fa, 0), v0, O0); O1 = MFMA32(fb_get(fa, 1), v0, O1); O1 = MFMA32(fb_get(fa, 2), v1, O1); }
            fb_wait(fb); fb_issue_kt(fa, 0, 0, lane);
            { const bf16x8 v0 = pack_acc(V0, 1), v1 = pack_acc(V1, 1);
              O0 = MFMA32(fb_get(fb, 0), v0, O0); O1 = MFMA32(fb_get(fb, 1), v0, O1); O1 = MFMA32(fb_get(fb, 2), v1, O1); }
#pragma unroll
            for (int i = 0; i < 16; ++i) { V0[i] *= EK[crow(i, hh)]; V1[i] *= EK[32 + crow(i, hh)]; }
#define SCAN_S4(F, kp, s_) do { const bf16x8 v0_ = pack_acc(V0, s_), v1_ = pack_acc(V1, s_); \
                S[2 * kp] = MFMA32(fb_get(F, 0), v0_, S[2 * kp]); S[2 * kp] = MFMA32(fb_get(F, 1), v1_, S[2 * kp]); \
                S[2 * kp + 1] = MFMA32(fb_get(F, 2), v0_, S[2 * kp + 1]); S[2 * kp + 1] = MFMA32(fb_get(F, 3), v1_, S[2 * kp + 1]); } while (0)
            fb_wait(fa); fb_issue_kt(fb, 1, 0, lane); SCAN_S4(fa, 0, 0);
            fb_wait(fb); fb_issue_kt(fa, 0, 1, lane); SCAN_S4(fb, 1, 0);
            fb_wait(fa); fb_issue_kt(fb, 1, 1, lane); SCAN_S4(fa, 0, 1);
            fb_wait(fb); SCAN_S4(fb, 1, 1);
#undef SCAN_S4
            if (n >= 4) {
#pragma unroll
                for (int i = 0; i < 16; ++i) {
                    OST[crow(i, hh) * 136 + dv0 + r] = f2bf(O0[i]);
                    OST[(32 + crow(i, hh)) * 136 + dv0 + r] = f2bf(O1[i]); }
            }
        }
    }
    __syncthreads();
#pragma unroll
    for (int ps = 0; ps < 2; ++ps) { const int tau = (tid >> 4) + 32 * ps, seg = tid & 15;
        *(u32x4*)(O + (size_t)scan_row(67, tau, b, dir) * 2048 + h * 128 + seg * 8) = *(const LAS u32x4*)(OST + tau * 136 + seg * 8); }
#undef SCAN_PREFETCH
}
DI void job_gdnin(const Params& p, int item) {
    const size_t e0 = (size_t)item * 4096 + tidx() * 8;
    const bf16_t* OF = (const bf16_t*)p.out; const bf16_t* OB = (const bf16_t*)p.out + (size_t)NTOK * D; bf16_t* ZG = (bf16_t*)(p.ws + OFF_X);
    const u32x4 a = *(const u32x4*)(OF + e0), bq = *(const u32x4*)(OB + e0), z = *(const u32x4*)(ZG + e0);
    const unsigned aw[4] = {a.x, a.y, a.z, a.w}, bw[4] = {bq.x, bq.y, bq.z, bq.w}, zw[4] = {z.x, z.y, z.z, z.w};
    float o[8]; float ss = 0.f;
#pragma unroll
    for (int q = 0; q < 4; ++q) { o[2 * q] = bflo(aw[q]) + bflo(bw[q]); o[2 * q + 1] = bfhi(aw[q]) + bfhi(bw[q]); ss += o[2 * q] * o[2 * q] + o[2 * q + 1] * o[2 * q + 1]; }
    ss += __shfl_xor(ss, 1); ss += __shfl_xor(ss, 2); ss += __shfl_xor(ss, 4); ss += __shfl_xor(ss, 8);
    const float rs = __builtin_amdgcn_rsqf(ss * (1.0f / 128.0f) + 1e-6f);
    const float* gn = p.in[22] + (e0 & 127);
    unsigned ow[4];
#pragma unroll
    for (int q = 0; q < 4; ++q) ow[q] = pk2(o[2 * q] * rs * gn[2 * q] * siluf_(bflo(zw[q])), o[2 * q + 1] * rs * gn[2 * q + 1] * siluf_(bfhi(zw[q])));
    *(u32x4*)(ZG + e0) = (u32x4){ow[0], ow[1], ow[2], ow[3]};
}
DI void job_final(const Params& p, int item) {
    const int lane = tidx() & 63, w = tidx() >> 6;
    const size_t row = (size_t)(item * 8 + w);
    const bf16_t* xr = (const bf16_t*)(p.ws + OFF_H) + row * 2048;
    float* orow = p.out + row * 2048;
    const float* nw = p.in[28];
    f32x4 xv[8]; float ss = 0.f;
#pragma unroll
    for (int i = 0; i < 8; ++i) { const u32x2 q = *(const u32x2*)(xr + (i * 64 + lane) * 4); xv[i] = (f32x4){bflo(q.x), bfhi(q.x), bflo(q.y), bfhi(q.y)};
        ss += xv[i][0] * xv[i][0] + xv[i][1] * xv[i][1] + xv[i][2] * xv[i][2] + xv[i][3] * xv[i][3]; }
    ss = wave_sum(ss);
    const float rstd = 1.0f / sqrtf(ss * (1.0f / 2048.0f) + 1e-6f);
#pragma unroll
    for (int i = 0; i < 8; ++i) { const int k = (i * 64 + lane) * 4; const f32x4 g = *(const f32x4*)(nw + k); *(f32x4*)(orow + k) = xv[i] * rstd * g; }
}


#define XB_TMO      128
#define XB_XCNT(j)  (256  + 64 * (j))
#define XB_XSUB(j)  (1280 + 64 * (j))
#define XB_XGEN(j)  (2304 + 64 * (j))
#define XB_TOP      3328
#define XB_TOPGEN   3392
#define XCD_BAR_WORDS 3456
#define XB_SPIN_CAP (1u << 18)
DI unsigned xb_ld(unsigned* p)              { return __hip_atomic_load(p, __ATOMIC_RELAXED, __HIP_MEMORY_SCOPE_AGENT); }
DI unsigned xb_add(unsigned* p, unsigned v) { return __hip_atomic_fetch_add(p, v, __ATOMIC_RELAXED, __HIP_MEMORY_SCOPE_AGENT); }
DI unsigned xb_xcc_id() { return (unsigned)__builtin_amdgcn_s_getreg((3 << 11) | 20) & 0xFu; }
#define XB_SPIN(cond, bar) do { unsigned _sp = 0; while (cond) { __builtin_amdgcn_s_sleep(8); \
    if ((++_sp & 255u) == 0u) { if (xb_ld(&(bar)[XB_TMO])) break; if (_sp > XB_SPIN_CAP) { atomicAdd(&(bar)[XB_TMO], 1u); break; } } } } while (0)
struct XcdBarrier { unsigned* bar; unsigned x; volatile LAS unsigned* st; };
DI XcdBarrier xcd_barrier_post(unsigned* bar, volatile LAS unsigned* st) {
    XcdBarrier b; b.bar = bar; b.x = xb_xcc_id(); b.st = st;
    if (threadIdx.x == 0) (void)xb_add(&bar[XB_XCNT(b.x)], 1u);
    return b;
}
DI void xcd_barrier_complete(unsigned* bar, unsigned x, unsigned& nloc, unsigned& nx) {
    const unsigned G = gridDim.x * gridDim.y * gridDim.z;
    unsigned sum, cnt, mine, sp = 0u;
    for (;;) {
        sum = 0u; cnt = 0u; mine = 0u;
#pragma unroll
        for (unsigned j = 0; j < 16; ++j) { const unsigned c = xb_ld(&bar[XB_XCNT(j)]); sum += c; cnt += (c > 0u) ? 1u : 0u; mine = (j == x) ? c : mine; }
        if (sum == G) break;
        __builtin_amdgcn_s_sleep(1);
        if ((++sp & 255u) == 0u) { if (xb_ld(&bar[XB_TMO])) break; if (sp > XB_SPIN_CAP) { atomicAdd(&bar[XB_TMO], 1u); break; } }
    }
    nloc = mine > 0u ? mine : 1u; nx = cnt > 0u ? cnt : 1u;
}
DI void xcd_barrier(const XcdBarrier& b) {
    asm volatile("s_waitcnt vmcnt(0)" ::: "memory");
    __syncthreads();
    if (threadIdx.x == 0) {
        unsigned* bar = b.bar;
        __builtin_amdgcn_s_waitcnt(0);
        unsigned nloc = b.st[0], nx = b.st[1];
        if (nloc == 0u) { xcd_barrier_complete(bar, b.x, nloc, nx); b.st[0] = nloc; b.st[1] = nx; }
        const unsigned old = xb_add(&bar[XB_XSUB(b.x)], 1u);
        const unsigned gen = old / nloc;
        if (old + 1u == (gen + 1u) * nloc) {
            __builtin_amdgcn_fence(__ATOMIC_RELEASE, "agent");
            asm volatile("s_waitcnt vmcnt(0)" ::: "memory");
            const unsigned og = xb_add(&bar[XB_TOP], 1u);
            const unsigned tg = og / nx;
            if (og + 1u == (tg + 1u) * nx) xb_add(&bar[XB_TOPGEN], 1u);
            else XB_SPIN(xb_ld(&bar[XB_TOPGEN]) == tg, bar);
            __builtin_amdgcn_fence(__ATOMIC_ACQUIRE, "agent");
            xb_add(&bar[XB_XGEN(b.x)], 1u);
            asm volatile("s_waitcnt vmcnt(0)" ::: "memory");
        } else {
            XB_SPIN(xb_ld(&bar[XB_XGEN(b.x)]) == gen, bar);
            __builtin_amdgcn_fence(__ATOMIC_ACQUIRE, "agent");
            asm volatile("s_waitcnt vmcnt(0)" ::: "memory");
        }
    }
    __syncthreads();
}

constexpr int NPHASE = 20;
DI void run_phase(const Params& p, int ph, LAS unsigned char* lds) {
    const int G = gridDim.x, bid = blockIdx.x;
    unsigned char* ws = p.ws;
    bf16_t* Hb = (bf16_t*)(ws + OFF_H);
    bf16_t* WTA = (bf16_t*)(ws + OFF_WTA); bf16_t* WTB = (bf16_t*)(ws + OFF_WTB); bf16_t* WSM = (bf16_t*)(ws + OFF_WSM);
    bf16_t* BIG = (bf16_t*)(ws + OFF_BIG);
    const float* MOD = (const float*)(ws + OFF_MOD);
    pg8::StaticOrder SO;
    switch (ph) {
    case 0: {
        const int n0 = 384, n2 = 48 * 16, tot = n0 + n2;
        for (int u = bid; u < tot; u += G) {
            if (u < n0) job_modp(p, u, lds);
            else convert_item(p.in[8], DIN, D, WTA, u - n0, 0, lds);
        }
    } break;
    case 1: {
        const int n0 = 120, n1 = 272, n2 = 0, n3 = 50 * 16, tot = n0 + n1 + n2 + n3;
        for (int u = bid; u < tot; u += G) {
            if (u < n0) { const int e = u * 512 + tidx(); const int v = e / 12288, col = e % 12288; float a = p.in[5][col];
                for (int pt = 0; pt < 16; ++pt) a += ((const float*)(ws + OFF_MODP))[((size_t)pt * 5 + v) * 12288 + col];
                ((float*)(ws + OFF_MOD))[e] = a; }
            else if (u < n0 + n1) { const int it = u - n0;
                if (it < 256) job_hrows<false>(p.in[0] + (size_t)it * 64 * 2048, p.in[6], (const float*)(ws + OFF_MODP), 16, p.in[5], it >> 6, 0, 1, Hb + (size_t)it * 64 * 2048, lds);
                else job_hrows<false>(p.in[2] + (size_t)(it - 256) * 64 * 2048, p.in[6], (const float*)(ws + OFF_MODP), 16, p.in[5], 4, 0, 1, Hb + (size_t)it * 64 * 2048, lds); }
            else convert_item(p.in[8], DIN, D, WTB, u - n0 - n1 - n2, 1, lds);
        }
    } break;
    case 3: {
        hyconv_pipe(p, lds, bid, G);
        for (int u = bid; u < 48 * 16; u += G) convert_item(p.in[8], DIN, D, WTA, u, 2, lds);
        { const int wv = tidx() >> 6; for (int u = bid * 8 + wv; u < 2048; u += G * 8) job_taps_mfma(p, u); }
    } break;
    case 4: {
        longconv_init(lds);
        longconv_pipe(p, lds, bid, G);
    } break;
    case 5: {
        hmix_pipe(p, lds, bid, G);
    } break;
    case 6: {
        pg8::Gemm g{Hb, WTB, MTOT, 6400, D}; SO.init(MTOT, 6400, G, bid);
        EpiBf16 E{BIG, 6144, 0, 24, (float*)(ws + OFF_SC), p.in[20], p.in[21]};
        pg8::gemm_phase(lds, g, SO, E);
        { const int nfull = 1700 % G, nidle = G - nfull;
          if (nfull != 0 && bid >= nfull) { __syncthreads();
              for (int u = bid - nfull; u < 768 + 512; u += nidle) {
                  if (u < 768) { const int wi = u >> 8; convert_item(p.in[23 + wi], D, D, WSM + (size_t)wi * D * D, u & 255, 3, lds); }
                  else job_filt_hidden(p, u - 768, lds); } }
          else if (nfull == 0) { __syncthreads();
              for (int u = bid; u < 768 + 512; u += G) {
                  if (u < 768) { const int wi = u >> 8; convert_item(p.in[23 + wi], D, D, WSM + (size_t)wi * D * D, u & 255, 3, lds); }
                  else job_filt_hidden(p, u - 768, lds); } } }
    } break;
    case 7: {
        qkvconv_latent_pipe(p, lds, bid, G);
        for (int u = 12288 + bid; u < 12288 + 192 + 544; u += G) { if (u < 12288 + 192) job_qkvconv(p, u, lds); else job_scal(p, u - 12288 - 192); }
    } break;
    case 19: {
        const int wv = tidx() >> 6;
        for (int u = bid * 8 + wv; u < 8704; u += G * 8) job_prep_T(p, u, lds + wv * PREP_WAVE_BYTES);
    } break;
    case 8: {
        pg8::Gemm g{Hb, WTA, NTOK, 6144, D};
        EpiBf16 E{(bf16_t*)(ws + OFF_X), 6144, 0, -1, nullptr, nullptr, nullptr};
        pg8::DynOrder DO; DO.nN = 24; DO.ntiles = 1536; DO.counters = (unsigned*)(ws + OFF_BAR) + 3456; DO.slot = (volatile LAS int*)(lds + LDS_BYTES - 32);
        if (G == 256) { if ((bid & 7) < 4) job_scan(p, (bid >> 3) * 4 + (bid & 7), lds); }
        else { for (int u = bid; u < 128; u += G) job_scan(p, u, lds); }
        __syncthreads();
        pg8::gemm_phase(lds, g, DO, E);
    } break;
    case 9: {
        pg8::Gemm g{Hb, WTA, NTOK, 6144, D}; SO.init(NTOK, 6144, G, bid);
        EpiZgGate E{(bf16_t*)(ws + OFF_X), (bf16_t*)(ws + OFF_GATE)};
        pg8::gemm_phase(lds, g, SO, E);
    } break;
    case 10: {
        for (int u = bid; u < 8192; u += G) job_gdnin(p, u);
    } break;
    case 12: {
        { pg8::Gemm g{(const bf16_t*)(ws + OFF_BIG + 2 * SZ67), WSM, NTOK, D, D}; SO.init(NTOK, D, G, bid);
          EpiGateMul E{BIG, nullptr, (const bf16_t*)(ws + OFF_GATE), 0};
          pg8::gemm_phase(lds, g, SO, E); }
        asm volatile("s_waitcnt vmcnt(0)" ::: "memory"); __syncthreads();
        { pg8::Gemm g{(const bf16_t*)(ws + OFF_X), WSM + (size_t)D * D, NTOK, D, D}; SO.init(NTOK, D, G, bid);
          EpiGateMul E{(bf16_t*)(ws + OFF_BIG + SZ67), BIG, (const bf16_t*)(ws + OFF_GATE), 2048};
          pg8::gemm_phase(lds, g, SO, E); }
    } break;
    case 14: {
        pg8::Gemm g{(const bf16_t*)(ws + OFF_BIG + SZ67), WSM + (size_t)2 * D * D, NTOK, D, D}; SO.init(NTOK, D, G, bid);
        EpiResidualBf<false> E{(bf16_t*)p.out, p.in[0], MOD, 2};
        pg8::gemm_phase(lds, g, SO, E);
    } break;
    case 15: {
        const int n0 = 256, n1 = 88 * 16, n2 = 16 * 44, tot = n0 + n1 + n2;
        for (int u = bid; u < tot; u += G) {
            if (u < n0) job_hrows<true>((const bf16_t*)p.out + (size_t)u * 64 * 2048, p.in[7], MOD, 1, nullptr, u >> 6, 3, 4, Hb + (size_t)u * 64 * 2048, lds);
            else if (u < n0 + n1) convert_item(p.in[26], 2 * DFF, D, (bf16_t*)(ws + OFF_WUP), u - n0, 4, lds);
            else convert_item(p.in[27], D, DFF, (bf16_t*)(ws + OFF_WDN), u - n0 - n1, 3, lds);
        }
    } break;
    case 16: {
        pg8::Gemm g{Hb, (const bf16_t*)(ws + OFF_WUP), NTOK, 2 * DFF, D}; SO.init(NTOK, 2 * DFF, G, bid);
        EpiSwiglu E{BIG};
        pg8::gemm_phase(lds, g, SO, E);
    } break;
    case 17: {
        pg8::Gemm g{BIG, (const bf16_t*)(ws + OFF_WDN), NTOK, D, DFF}; SO.init(NTOK, D, G, bid);
        EpiResidualBf<true> E{Hb, (const bf16_t*)p.out, MOD, 5};
        pg8::gemm_phase(lds, g, SO, E);
    } break;
    case 18: {
        for (int u = bid; u < 2048; u += G) job_final(p, u);
    } break;
    default: break;
    }
}

#if MULTI_LAUNCH
template <int PH>
__global__ void __launch_bounds__(NTHREADS) phase_kernel(Params p) {
    extern __shared__ __attribute__((aligned(16))) unsigned char lds_raw[];
    run_phase(p, PH, (LAS unsigned char*)lds_raw);
}
template <int PH> static void launch_phases(const Params& p, int grid, hipStream_t stream) {
    hipFuncSetAttribute((const void*)phase_kernel<PH>, hipFuncAttributeMaxDynamicSharedMemorySize, LDS_BYTES);
    hipLaunchKernelGGL(phase_kernel<PH>, dim3(grid), dim3(NTHREADS), LDS_BYTES, stream, p);
    if constexpr (PH + 1 < NPHASE) launch_phases<PH + 1>(p, grid, stream);
}
#else
__global__ void __launch_bounds__(NTHREADS) fwd_megakernel(Params p) {
    extern __shared__ __attribute__((aligned(16))) unsigned char lds_raw[];
    LAS unsigned char* lds = (LAS unsigned char*)lds_raw;
    cg::grid_group grid = cg::this_grid();
    volatile LAS unsigned* bst = (volatile LAS unsigned*)(lds + LDS_BYTES - 16);
    if (threadIdx.x < 4) bst[threadIdx.x] = 0u;
    __syncthreads();
    (void)xcd_barrier_post((unsigned*)(p.ws + OFF_BAR), bst);
#define XB_NOW() xcd_barrier(XcdBarrier{(unsigned*)(p.ws + OFF_BAR), xb_xcc_id(), (volatile LAS unsigned*)(lds + LDS_BYTES - 16)})
#ifndef PROBE_MASK
#define PROBE_MASK 0
#endif
#ifndef PROBE_SYNCS
#define PROBE_SYNCS 0
#endif
#define PH(k) run_phase(p, k, lds); XB_NOW(); if ((PROBE_MASK >> k) & 1) { run_phase(p, k, lds); XB_NOW(); }
    run_phase(p, 0, lds); grid.sync();
    PH(1) PH(6) PH(7) PH(19) PH(8) PH(3) PH(4) PH(5) PH(9) PH(10) PH(12) PH(14) PH(15) PH(16) PH(17)
    for (int i = 0; i < PROBE_SYNCS; ++i) XB_NOW();
    run_phase(p, 18, lds);
#undef PH
}
#endif

extern "C" void kernel_launch(void* const* d_in, const int* in_sizes, int n_in, void* d_out, int out_size, void* d_ws, size_t ws_size, hipStream_t stream) {
    static int grid = 0;
    if (grid == 0) {
        if (n_in != 29 || ws_size < WS_END) { fprintf(stderr, "kernel_launch: need 29 inputs and %zu B workspace; got %d, %zu\n", (size_t)WS_END, n_in, ws_size); grid = -1; return; }
        int dev = 0, cus = 0;
        hipGetDevice(&dev);
        hipDeviceGetAttribute(&cus, hipDeviceAttributeMultiprocessorCount, dev);
#if !MULTI_LAUNCH
        int per_cu = 0;
        hipFuncSetAttribute((const void*)fwd_megakernel, hipFuncAttributeMaxDynamicSharedMemorySize, LDS_BYTES);
        hipOccupancyMaxActiveBlocksPerMultiprocessor(&per_cu, (const void*)fwd_megakernel, NTHREADS, LDS_BYTES);
        if (per_cu < 1) { fprintf(stderr, "kernel_launch: occupancy query says %d blocks per CU\n", per_cu); }
#endif
        grid = cus > 0 ? cus : 256;
    }
    if (grid < 0) return;
    Params p{};
    for (int i = 0; i < 29; ++i) p.in[i] = (const float*)d_in[i];
    p.out = (float*)d_out; p.ws = (unsigned char*)d_ws;
#if MULTI_LAUNCH
    launch_phases<0>(p, grid, stream);
#else
    if (hipMemsetAsync((char*)d_ws + OFF_BAR, 0, 16384, stream) != hipSuccess) { fprintf(stderr, "kernel_launch: memset of barrier words failed\n"); return; }
    void* args[] = {&p};
    hipError_t e = hipLaunchCooperativeKernel((const void*)fwd_megakernel, dim3(grid), dim3(NTHREADS), args, LDS_BYTES, stream);
    if (e != hipSuccess) fprintf(stderr, "cooperative launch failed: %s (grid %d)\n", hipGetErrorString(e), grid);
#endif
}
```
